# Optimizing an MI355X kernel written in HIP

```python
import jax, jax.numpy as jnp
from jax import lax
import numpy as np

D_MODEL = 1024
BATCH = 16
SEQ = 2048
DEPTH = 1

CHUNK = 64
HEAD_DIM = 64
SWA_HEADS = 8
SWA_KV_HEADS = 2
SWA_GROUP = SWA_HEADS // SWA_KV_HEADS
WINDOW = 128
WINDOW_CHUNKS = WINDOW // CHUNK
SWA_BLOCK = 128
SB_HEADS = 8
SB_BLOCK = 128
NUM_BUCKETS = 32
MAX_DISTANCE = 128
N_EXPERTS = 256
TOP_K = 8
N_GROUPS = 8
TOPK_GROUPS = 4
EXPERT_DIM = 256
SHARED_DIM = 256
ROUTED_SCALE = 2.5
MOE_BLOCK = 128
RMS_EPS = 1e-6
N_MOD = 6
NEG_INF = -1e30

QA_W = SWA_HEADS * HEAD_DIM
KVA_W = SWA_KV_HEADS * HEAD_DIM
QB_W = SB_HEADS * HEAD_DIM
IN_WIDTH = QA_W + 2 * KVA_W + 3 * QB_W + 2 * D_MODEL
SPLITS = [QA_W, QA_W + KVA_W, QA_W + 2 * KVA_W, QA_W + 2 * KVA_W + QB_W,
          QA_W + 2 * KVA_W + 2 * QB_W, QA_W + 2 * KVA_W + 3 * QB_W,
          QA_W + 2 * KVA_W + 3 * QB_W + D_MODEL]

kernel_name = "hybrid_swa_sink_stickbreak_moe_block"


def rmsnorm(x, g):
    xf = x.astype(jnp.float32)
    y = xf * lax.rsqrt(jnp.mean(xf * xf, axis=-1, keepdims=True) + RMS_EPS)
    return (y * g.astype(jnp.float32)).astype(x.dtype)


def t5_buckets():
    i = np.arange(SWA_BLOCK)[:, None]
    j = np.arange(2 * SWA_BLOCK)[None, :]
    rel = (j - SWA_BLOCK) - i
    nb = NUM_BUCKETS // 2
    bucket = (rel > 0).astype(np.int32) * nb
    n = np.abs(rel)
    max_exact = nb // 2
    large = max_exact + (np.log(np.maximum(n, 1) / max_exact)
                         / np.log(MAX_DISTANCE / max_exact) * (nb - max_exact)).astype(np.int32)
    large = np.minimum(large, nb - 1)
    return (bucket + np.where(n < max_exact, n, large)).astype(np.int32)


def swa_sink_attention(q, k, v, sinks, rel_bias):
    B, S = q.shape[0], q.shape[1]
    nb = S // SWA_BLOCK
    qb = q.reshape(B, nb, SWA_BLOCK, SWA_KV_HEADS, SWA_GROUP, HEAD_DIM)

    def band(t):
        tb = t.reshape(B, nb, SWA_BLOCK, SWA_KV_HEADS, HEAD_DIM)
        prev = jnp.concatenate([jnp.zeros_like(tb[:, :1]), tb[:, :-1]], axis=1)
        return jnp.concatenate([prev, tb], axis=2)

    kb, vb = band(k), band(v)
    logits = jnp.einsum('bnqhgd,bnkhd->bnhgqk', qb, kb,
                        preferred_element_type=jnp.float32) * (HEAD_DIM ** -0.5)
    bias = rel_bias.astype(jnp.float32)[t5_buckets()]
    bias = bias.transpose(2, 0, 1).reshape(SWA_KV_HEADS, SWA_GROUP, SWA_BLOCK, 2 * SWA_BLOCK)
    logits = logits + bias
    blk = jnp.arange(nb)[:, None, None] * SWA_BLOCK
    qpos = blk + jnp.arange(SWA_BLOCK)[None, :, None]
    kpos = blk - SWA_BLOCK + jnp.arange(2 * SWA_BLOCK)[None, None, :]
    qc, kc = qpos // CHUNK, kpos // CHUNK
    valid = (kpos >= 0) & (kc <= qc) & (kc >= qc - WINDOW_CHUNKS)
    logits = jnp.where(valid[None, :, None, None], logits, NEG_INF)
    sink_col = jnp.broadcast_to(
        sinks.astype(jnp.float32).reshape(1, 1, SWA_KV_HEADS, SWA_GROUP, 1, 1),
        logits.shape[:-1] + (1,))
    probs = jax.nn.softmax(jnp.concatenate([logits, sink_col], axis=-1), axis=-1)[..., :-1]
    out = jnp.einsum('bnhgqk,bnkhd->bnqhgd', probs.astype(v.dtype), vb)
    return out.reshape(B, S, QA_W)


def stick_breaking_attention(q, k, v):
    B, S, H, dh = q.shape
    outs = []
    for blk in range(S // SB_BLOCK):
        q0 = blk * SB_BLOCK
        L = q0 + SB_BLOCK
        z = jnp.einsum('bqhd,bkhd->bhqk', q[:, q0:L], k[:, :L],
                       preferred_element_type=jnp.float32) * (dh ** -0.5)
        causal = jnp.arange(L)[None, :] < (q0 + jnp.arange(SB_BLOCK))[:, None]
        log_keep = jnp.where(causal, jax.nn.log_sigmoid(-z), 0.0)
        log_rest = lax.cumsum(log_keep, axis=3, reverse=True) - log_keep
        w = jnp.where(causal, jnp.exp(jax.nn.log_sigmoid(z) + log_rest), 0.0)
        outs.append(jnp.einsum('bhqk,bkhd->bqhd', w.astype(v.dtype), v[:, :L]))
    return jnp.concatenate(outs, axis=1).reshape(B, S, H * dh)


def route(h, w_router, router_bias):
    T = h.shape[0]
    scores = jax.nn.sigmoid(jnp.matmul(h, w_router, preferred_element_type=jnp.float32))
    choice = scores + router_bias.astype(jnp.float32)
    grouped = choice.reshape(T, N_GROUPS, N_EXPERTS // N_GROUPS)
    group_score = lax.top_k(grouped, 2)[0].sum(-1)
    _, top_groups = lax.top_k(group_score, TOPK_GROUPS)
    group_mask = jnp.any(top_groups[..., None] == jnp.arange(N_GROUPS)[None, None, :], axis=1)
    expert_mask = jnp.repeat(group_mask, N_EXPERTS // N_GROUPS, axis=1)
    _, idx = lax.top_k(jnp.where(expert_mask, choice, -jnp.inf), TOP_K)
    w = jnp.take_along_axis(scores, idx, axis=1)
    w = w / jnp.sum(w, axis=-1, keepdims=True) * ROUTED_SCALE
    return idx, w


def routed_experts(h, idx, wts, w_gate, w_up, w_down):
    T, D = h.shape
    N = T * TOP_K
    e_flat = idx.reshape(N)
    tok_flat = jnp.arange(N, dtype=jnp.int32) // TOP_K
    w_flat = wts.reshape(N)
    order = jnp.argsort(e_flat)
    e_sorted, tok_sorted, w_sorted = e_flat[order], tok_flat[order], w_flat[order]
    counts = jnp.bincount(e_flat, length=N_EXPERTS)
    start = jnp.cumsum(counts) - counts
    pad_counts = (counts + MOE_BLOCK - 1) // MOE_BLOCK * MOE_BLOCK
    pad_end = jnp.cumsum(pad_counts)
    pad_start = pad_end - pad_counts
    pos = pad_start[e_sorted] + jnp.arange(N) - start[e_sorted]
    n_blocks = -(-N // MOE_BLOCK) + N_EXPERTS
    tok_pad = jnp.full((n_blocks * MOE_BLOCK,), T, jnp.int32).at[pos].set(tok_sorted)
    w_pad = jnp.zeros((n_blocks * MOE_BLOCK,), h.dtype).at[pos].set(w_sorted.astype(h.dtype))
    block_e = jnp.minimum(
        jnp.searchsorted(pad_end, jnp.arange(n_blocks) * MOE_BLOCK, side='right'), N_EXPERTS - 1)
    h_pad = jnp.concatenate([h, jnp.zeros((1, D), h.dtype)], axis=0)

    def body(acc, blk):
        tok, wt, e = blk
        xb = h_pad[tok]
        hid = jax.nn.silu(xb @ w_gate[e]) * (xb @ w_up[e])
        yb = hid @ w_down[e]
        return acc.at[tok].add(yb * wt[:, None]), None

    acc, _ = lax.scan(body, jnp.zeros((T + 1, D), h.dtype),
                      (tok_pad.reshape(n_blocks, MOE_BLOCK), w_pad.reshape(n_blocks, MOE_BLOCK), block_e))
    return acc[:T]


def setup_inputs(seed: int = 0) -> dict:
    key = jax.random.key(seed)
    ks = jax.random.split(key, 24)
    f32 = jnp.float32
    D, L = D_MODEL, DEPTH

    def nrm(k, shape, scale):
        return jax.random.normal(k, shape, f32) * scale

    return {
        "x": nrm(ks[0], (BATCH, SEQ, D), 1.0),
        "c": nrm(ks[1], (BATCH, D), 1.0),
        "w_ada": nrm(ks[2], (L, D, N_MOD * D), 0.5 * D ** -0.5),
        "b_ada": nrm(ks[3], (L, N_MOD * D), 0.02),
        "g_pre_mix": 1.0 + nrm(ks[4], (L, D), 0.05),
        "g_post_mix": 1.0 + nrm(ks[5], (L, D), 0.05),
        "w_in": nrm(ks[6], (L, D, IN_WIDTH), D ** -0.5),
        "attn_sinks": nrm(ks[7], (L, SWA_HEADS), 0.5),
        "rel_bias": nrm(ks[8], (NUM_BUCKETS, SWA_HEADS), 0.5),
        "w_branch_a": nrm(ks[9], (L, QA_W, D), QA_W ** -0.5),
        "w_branch_b": nrm(ks[10], (L, QB_W, D), QB_W ** -0.5),
        "w_out": nrm(ks[11], (L, D, D), D ** -0.5),
        "g_pre_ffn": 1.0 + nrm(ks[12], (L, D), 0.05),
        "g_post_ffn": 1.0 + nrm(ks[13], (L, D), 0.05),
        "w_router": nrm(ks[14], (L, D, N_EXPERTS), D ** -0.5),
        "router_bias": nrm(ks[15], (L, N_EXPERTS), 0.01),
        "w_gate_e": nrm(ks[16], (L, N_EXPERTS, D, EXPERT_DIM), D ** -0.5),
        "w_up_e": nrm(ks[17], (L, N_EXPERTS, D, EXPERT_DIM), D ** -0.5),
        "w_down_e": nrm(ks[18], (L, N_EXPERTS, EXPERT_DIM, D), EXPERT_DIM ** -0.5),
        "w_gate_s": nrm(ks[19], (L, D, SHARED_DIM), D ** -0.5),
        "w_up_s": nrm(ks[20], (L, D, SHARED_DIM), D ** -0.5),
        "w_down_s": nrm(ks[21], (L, SHARED_DIM, D), SHARED_DIM ** -0.5),
    }


def reference(x, c, w_ada, b_ada, g_pre_mix, g_post_mix, w_in, attn_sinks, rel_bias,
              w_branch_a, w_branch_b, w_out, g_pre_ffn, g_post_ffn, w_router, router_bias,
              w_gate_e, w_up_e, w_down_e, w_gate_s, w_up_s, w_down_s):
    B, S, D = x.shape
    for l in range(DEPTH):
        mod = (jax.nn.silu(c) @ w_ada[l] + b_ada[l]).reshape(B, N_MOD, 1, D)
        shift1, scale1, gate1 = mod[:, 0], mod[:, 1], mod[:, 2]
        shift2, scale2, gate2 = mod[:, 3], mod[:, 4], mod[:, 5]

        h = rmsnorm(x, g_pre_mix[l]) * (1 + scale1) + shift1
        proj = h @ w_in[l]
        qa, ka, va, qb, kb, vb, ga, gb = jnp.split(proj, SPLITS, axis=-1)
        ya = swa_sink_attention(qa.reshape(B, S, SWA_HEADS, HEAD_DIM),
                                ka.reshape(B, S, SWA_KV_HEADS, HEAD_DIM),
                                va.reshape(B, S, SWA_KV_HEADS, HEAD_DIM),
                                attn_sinks[l], rel_bias)
        yb = stick_breaking_attention(qb.reshape(B, S, SB_HEADS, HEAD_DIM),
                                      kb.reshape(B, S, SB_HEADS, HEAD_DIM),
                                      vb.reshape(B, S, SB_HEADS, HEAD_DIM))
        merged = jax.nn.sigmoid(ga) * (ya @ w_branch_a[l]) + jax.nn.sigmoid(gb) * (yb @ w_branch_b[l])
        x = x + gate1 * rmsnorm(merged @ w_out[l], g_post_mix[l])

        h2 = (rmsnorm(x, g_pre_ffn[l]) * (1 + scale2) + shift2).reshape(B * S, D)
        idx, wts = route(h2, w_router[l], router_bias[l])
        y = routed_experts(h2, idx, wts, w_gate_e[l], w_up_e[l], w_down_e[l])
        y = y + (jax.nn.silu(h2 @ w_gate_s[l]) * (h2 @ w_up_s[l])) @ w_down_s[l]
        x = x + gate2 * rmsnorm(y.reshape(B, S, D), g_post_ffn[l])
    return x
```

```cpp
#include <hip/hip_runtime.h>
#include <cstdio>
#include <cstdint>

#ifndef FAST_DENSE
#define FAST_DENSE 1
#endif
#ifndef FAST_MOE
#define FAST_MOE 1
#endif
#ifndef NEW_CVT
#define NEW_CVT 1
#endif
#ifndef CVT_IN_P0
#define CVT_IN_P0 0
#endif
#ifndef MOE1_FP8
#define MOE1_FP8 1
#endif
#ifndef MOE2_FP8
#define MOE2_FP8 1
#endif
#ifndef F8G
#define F8G 0
#endif
#ifndef F8B
#define F8B 0
#endif
#ifndef F8O
#define F8O 0
#endif
#ifndef MK_ONE_LAUNCH
#define MK_ONE_LAUNCH 1
#endif

#define GAS __attribute__((address_space(1)))
#define LAS __attribute__((address_space(3)))
typedef unsigned short bf16;
typedef float f32x4 __attribute__((ext_vector_type(4)));
typedef float f32x16 __attribute__((ext_vector_type(16)));
typedef short bf16x8 __attribute__((ext_vector_type(8)));
typedef short s16x4 __attribute__((ext_vector_type(4)));
typedef unsigned u32x4 __attribute__((ext_vector_type(4)));
typedef unsigned u32x2 __attribute__((ext_vector_type(2)));
typedef GAS unsigned gu32;

constexpr int NB = 16, SEQ = 2048, DM = 1024, T = NB * SEQ;
constexpr int INW = 4352;
constexpr int C_QA = 0, C_KA = 512, C_VA = 640, C_QB = 768, C_KB = 1280, C_VB = 1792, C_GA = 2304, C_GB = 3328;
constexpr int NE = 256, TOPK = 8, EDIM = 256;
constexpr int NASSIGN = T * TOPK;
constexpr int PADCAP = NASSIGN + NE * 256;
constexpr int NROWS_PAD = PADCAP + T;
constexpr int SH_TILE0 = PADCAP / 256;
constexpr float RMS_EPS = 1e-6f;
constexpr float LOG2E = 1.4426950408889634f;
constexpr float Y8_SCALE = 8.0f;
constexpr float ATT8_SCALE = 4.0f, MRG8_SCALE = 8.0f;
constexpr float HID8_SCALE = 4.0f;
constexpr float W8_SCALE = 64.0f;
constexpr int NWAVES = 8, NTHR = 512;
constexpr int LDS_BYTES = 147456;

constexpr size_t MiB = 1u << 20;
constexpr size_t WS_CTL = 0, CTL_ZERO_BYTES = 1 * MiB;
constexpr size_t WS_MOD = 1 * MiB;
constexpr size_t WS_BB = 2 * MiB;
constexpr size_t WS_TILEE = 3 * MiB;
constexpr size_t WS_WIN = 4 * MiB;
constexpr size_t WS_WIN8 = 9 * MiB;
constexpr size_t WS_WA = 13 * MiB, WS_WB = 14 * MiB, WS_WOUT = 15 * MiB, WS_WR = 17 * MiB;
constexpr size_t WS_WD = 20 * MiB;
constexpr size_t WS_WGU = 149 * MiB;
constexpr size_t WS_Y = 149 * MiB;
constexpr size_t WS_PROJ = 406 * MiB;
constexpr size_t WS_H2F8 = 564 * MiB;
constexpr size_t WS_XMID = 500 * MiB;
constexpr size_t WS_A1 = 678 * MiB;
constexpr size_t WS_A2 = 742 * MiB;
constexpr size_t WS_A3 = 806 * MiB;
constexpr size_t WS_IDX = 982 * MiB, WS_WT = 983 * MiB, WS_RANK = 984 * MiB, WS_POS = 985 * MiB;
constexpr size_t WS_TOKP = 986 * MiB, WS_YPOS = 988 * MiB, WS_WPAD = 990 * MiB, WS_END = 992 * MiB;
static_assert(WS_WD + (size_t)257 * 1024 * 256 * 2 <= WS_WGU, "wd");
static_assert(WS_WGU + (size_t)257 * 512 * 1024 * 2 <= WS_PROJ, "wgu");
static_assert(WS_PROJ + (size_t)T * INW * 2 <= WS_A1, "proj");
static_assert(WS_Y + (size_t)(NASSIGN + T + 1) * 1024 <= WS_XMID, "y");
static_assert(WS_A3 + (size_t)NROWS_PAD * 256 * 2 <= WS_IDX, "hid");
static_assert(WS_TOKP + (size_t)NROWS_PAD * 4 <= WS_YPOS && WS_YPOS + (size_t)NROWS_PAD * 4 <= WS_WPAD && WS_WPAD + (size_t)NROWS_PAD * 4 <= WS_END, "pad arrays");
constexpr int CW_BAR = 4096;
constexpr int CW_GCNT = 16384;
constexpr int CW_NRT = 16384 + 256;

__device__ const unsigned char T5B[384] = {
15,15,15,15,15,15,15,15,15,15,15,15,15,15,15,15,15,15,15,15,15,15,15,15,15,15,15,15,15,15,15,15,15,15,15,15,15,15,15,15,15,15,15,15,15,15,15,15,15,15,15,15,15,15,15,15,15,15,15,15,15,15,15,15,15,15,15,15,15,15,15,15,15,15,15,15,15,15,15,15,15,15,15,15,15,15,15,15,15,15,15,15,15,15,15,15,15,15,15,15,15,15,15,15,15,15,15,15,15,15,15,15,15,15,15,15,15,15,15,15,15,15,15,15,15,15,15,15,15,15,15,15,15,15,15,15,15,15,15,15,15,15,15,15,15,15,15,15,15,15,15,15,15,15,15,15,15,15,15,15,15,15,15,15,15,14,14,14,14,14,14,14,14,14,14,14,14,14,14,14,14,14,14,14,14,14,14,14,14,14,14,14,13,13,13,13,13,13,13,13,13,13,13,13,13,13,13,13,13,13,12,12,12,12,12,12,12,12,12,12,12,12,12,12,11,11,11,11,11,11,11,11,11,10,10,10,10,10,10,10,9,9,9,9,8,8,8,8,7,6,5,4,3,2,1,0,17,18,19,20,21,22,23,24,24,24,24,25,25,25,25,26,26,26,26,26,26,26,27,27,27,27,27,27,27,27,27,28,28,28,28,28,28,28,28,28,28,28,28,28,28,29,29,29,29,29,29,29,29,29,29,29,29,29,29,29,29,29,29,30,30,30,30,30,30,30,30,30,30,30,30,30,30,30,30,30,30,30,30,30,30,30,30,30,30,30,31,31,31,31,31,31,31,31,31,31,31,31,31,31,31,31,31,31,31,31,31,31,31,31,31,31,31,31,31,31,31,31,31,31,31,31,31,0};

#define LDS_WAIT() asm volatile("s_waitcnt lgkmcnt(0)" ::: "memory")
__device__ __forceinline__ unsigned f2bf(float f) { unsigned u = __builtin_bit_cast(unsigned, f); return (u + 0x7fffu + ((u >> 16) & 1u)) >> 16; }
__device__ __forceinline__ unsigned pk2(float lo, float hi) { return f2bf(lo) | (f2bf(hi) << 16); }
__device__ __forceinline__ float bf2f(unsigned short b) { return __builtin_bit_cast(float, (unsigned)b << 16); }
__device__ __forceinline__ float bflo(unsigned w) { return __builtin_bit_cast(float, w << 16); }
__device__ __forceinline__ float bfhi(unsigned w) { return __builtin_bit_cast(float, w & 0xffff0000u); }
__device__ __forceinline__ float ex2(float x) { return __builtin_amdgcn_exp2f(x); }
__device__ __forceinline__ float lg2(float x) { return __builtin_amdgcn_logf(x); }
__device__ __forceinline__ float sigmoidf_(float x) { return __builtin_amdgcn_rcpf(1.0f + ex2(-x * LOG2E)); }
__device__ __forceinline__ float wave_sum(float v) {
#pragma unroll
    for (int o = 1; o < 64; o <<= 1) v += __shfl_xor(v, o);
    return v;
}
__device__ __forceinline__ int crow(int r, int hi) { return (r & 3) + 8 * (r >> 2) + 4 * hi; }
__device__ __forceinline__ s16x4 vtr(const LAS unsigned char* p) {
    typedef short v4i16_t __attribute__((ext_vector_type(4)));
    return __builtin_bit_cast(s16x4, __builtin_amdgcn_ds_read_tr16_b64_v4i16((LAS v4i16_t*)p));
}

#define XB_TMO      128
#define XB_XCNT(j)  (256  + 64 * (j))
#define XB_XSUB(j)  (1280 + 64 * (j))
#define XB_XGEN(j)  (2304 + 64 * (j))
#define XB_TOP      3328
#define XB_TOPGEN   3392
#define XCD_BAR_WORDS 3456
#define XB_SPIN_CAP (1u << 18)
__device__ __forceinline__ unsigned xb_ld(unsigned* p)              { return __hip_atomic_load(p, __ATOMIC_RELAXED, __HIP_MEMORY_SCOPE_AGENT); }
__device__ __forceinline__ unsigned xb_add(unsigned* p, unsigned v) { return __hip_atomic_fetch_add(p, v, __ATOMIC_RELAXED, __HIP_MEMORY_SCOPE_AGENT); }
__device__ __forceinline__ unsigned xb_xcc_id() { return (unsigned)__builtin_amdgcn_s_getreg((3 << 11) | 20) & 0xFu; }
#define XB_SPIN(cond, bar) do { unsigned _sp = 0; while (cond) { __builtin_amdgcn_s_sleep(1); \
    if ((++_sp & 255u) == 0u) { if (xb_ld(&(bar)[XB_TMO])) break; if (_sp > XB_SPIN_CAP) { atomicAdd(&(bar)[XB_TMO], 1u); break; } } } } while (0)
struct XcdBarrier { unsigned* bar; unsigned x; volatile LAS unsigned* st; };
__device__ __forceinline__ XcdBarrier xcd_barrier_post(unsigned* bar, volatile LAS unsigned* st) {
    XcdBarrier b; b.bar = bar; b.x = xb_xcc_id(); b.st = st;
    if (threadIdx.x == 0) (void)xb_add(&bar[XB_XCNT(b.x)], 1u);
    return b;
}
__device__ __forceinline__ void xcd_barrier_complete(unsigned* bar, unsigned x, unsigned& nloc, unsigned& nx) {
    const unsigned G = gridDim.x * gridDim.y * gridDim.z;
    unsigned sum, cnt, mine, sp = 0u;
    for (;;) {
        sum = 0u; cnt = 0u; mine = 0u;
#pragma unroll
        for (unsigned j = 0; j < 16; ++j) { const unsigned c = xb_ld(&bar[XB_XCNT(j)]); sum += c; cnt += (c > 0u) ? 1u : 0u; mine = (j == x) ? c : mine; }
        if (sum == G) break;
        __builtin_amdgcn_s_sleep(1);
        if ((++sp & 255u) == 0u) { if (xb_ld(&bar[XB_TMO])) break; if (sp > XB_SPIN_CAP) { atomicAdd(&bar[XB_TMO], 1u); break; } }
    }
    nloc = mine > 0u ? mine : 1u; nx = cnt > 0u ? cnt : 1u;
}
__device__ __forceinline__ void xcd_barrier(const XcdBarrier& b) {
    asm volatile("s_waitcnt vmcnt(0)" ::: "memory");
    __syncthreads();
    if (threadIdx.x == 0) {
        unsigned* bar = b.bar;
        __builtin_amdgcn_s_waitcnt(0);
        unsigned nloc = b.st[0], nx = b.st[1];
        if (nloc == 0u) { xcd_barrier_complete(bar, b.x, nloc, nx); b.st[0] = nloc; b.st[1] = nx; }
        const unsigned old = xb_add(&bar[XB_XSUB(b.x)], 1u);
        const unsigned gen = old / nloc;
        if (old + 1u == (gen + 1u) * nloc) {
            __builtin_amdgcn_fence(__ATOMIC_RELEASE, "agent");
            asm volatile("s_waitcnt vmcnt(0)" ::: "memory");
            const unsigned og = xb_add(&bar[XB_TOP], 1u);
            const unsigned tg = og / nx;
            if (og + 1u == (tg + 1u) * nx) xb_add(&bar[XB_TOPGEN], 1u);
            else XB_SPIN(xb_ld(&bar[XB_TOPGEN]) == tg, bar);
            __builtin_amdgcn_fence(__ATOMIC_ACQUIRE, "agent");
            xb_add(&bar[XB_XGEN(b.x)], 1u);
            asm volatile("s_waitcnt vmcnt(0)" ::: "memory");
        } else {
            XB_SPIN(xb_ld(&bar[XB_XGEN(b.x)]) == gen, bar);
            __builtin_amdgcn_fence(__ATOMIC_ACQUIRE, "agent");
            asm volatile("s_waitcnt vmcnt(0)" ::: "memory");
        }
    }
    __syncthreads();
}

struct Ctx {
    LAS unsigned char* lds;
    int tid, lane, wave, G, blk;
    float* out; unsigned char* ws;
    __device__ __forceinline__ const float* in(int i) const {
#if defined(__HIP_DEVICE_COMPILE__)
        const void* k = (const void*)__builtin_amdgcn_kernarg_segment_ptr(); asm volatile("" : "+s"(k));
        const GAS float* g = ((const GAS float* const*)k)[i]; return (const float*)g;
#else
        return nullptr;
#endif
    }
};

__device__ __forceinline__ void sg_mainloop(LAS unsigned char* lds, const char* pa0, const char* pa1, const char* pb0, const char* pb1, const char* pb2, const char* pb3,
                                            int K, f32x16 (&acc)[2][2]) {
    const int tid = threadIdx.x, lane = tid & 63, wave = tid >> 6, r32 = lane & 31, hi = lane >> 5, wm = wave >> 2, wn = wave & 3;
#pragma unroll
    for (int a = 0; a < 2; ++a)
#pragma unroll
        for (int b = 0; b < 2; ++b)
#pragma unroll
            for (int r = 0; r < 16; ++r) acc[a][b][r] = 0.f;
    const int prow = tid >> 3, pch = tid & 7;
    const unsigned wa0 = pch * 2048 + prow * 16, wa1 = pch * 2048 + (prow + 64) * 16;
    const unsigned wb0 = 16384 + pch * 4096 + prow * 16;
    u32x4 va0, va1, vb0, vb1, vb2, vb3;
    va0 = *(const u32x4*)pa0; va1 = *(const u32x4*)pa1; vb0 = *(const u32x4*)pb0; vb1 = *(const u32x4*)pb1; vb2 = *(const u32x4*)pb2; vb3 = *(const u32x4*)pb3;
    for (int k0 = 0; k0 < K; k0 += 64) {
        __syncthreads();
        *(LAS u32x4*)(lds + wa0) = va0; *(LAS u32x4*)(lds + wa1) = va1;
        *(LAS u32x4*)(lds + wb0) = vb0; *(LAS u32x4*)(lds + wb0 + 1024) = vb1; *(LAS u32x4*)(lds + wb0 + 2048) = vb2; *(LAS u32x4*)(lds + wb0 + 3072) = vb3;
        __syncthreads();
        if (k0 + 64 < K) {
            const int o = (k0 + 64) * 2;
            va0 = *(const u32x4*)(pa0 + o); va1 = *(const u32x4*)(pa1 + o); vb0 = *(const u32x4*)(pb0 + o); vb1 = *(const u32x4*)(pb1 + o); vb2 = *(const u32x4*)(pb2 + o); vb3 = *(const u32x4*)(pb3 + o);
        }
#pragma unroll
        for (int ks = 0; ks < 4; ++ks) {
            bf16x8 af[2], bfv[2];
#pragma unroll
            for (int mt = 0; mt < 2; ++mt) af[mt] = *(const LAS bf16x8*)(lds + (2 * ks + hi) * 2048 + (wm * 64 + mt * 32 + r32) * 16);
#pragma unroll
            for (int j = 0; j < 2; ++j) bfv[j] = *(const LAS bf16x8*)(lds + 16384 + (2 * ks + hi) * 4096 + (j * 128 + wn * 32 + r32) * 16);
#pragma unroll
            for (int mt = 0; mt < 2; ++mt)
#pragma unroll
                for (int j = 0; j < 2; ++j) acc[mt][j] = __builtin_amdgcn_mfma_f32_32x32x16_bf16(bfv[j], af[mt], acc[mt][j], 0, 0, 0);
        }
    }
}


namespace pg8 {
constexpr int BM = 256, BK = 64, HALF = 128, HTB = HALF * BK * 2, NXCD = 8, WGM = 8;
__host__ __device__ __forceinline__ int lds_byte(int r, int c) { const int st = (r >> 4) * 2 + (c >> 5), rr = r & 15, cc = c & 31, ob = rr * 64 + cc * 2; return st * 1024 + (ob ^ (((ob >> 9) & 1) << 5)); }
__host__ __device__ __forceinline__ void stage_rc(int b, int& R, int& C) { const int st = b / 1024, sb = b % 1024, swz = sb ^ (((sb >> 9) & 1) << 5); R = (st >> 1) * 16 + swz / 64; C = (st & 1) * 32 + (swz % 64) / 2; }
__host__ __device__ __forceinline__ int perm32(int rho) { const int n = rho >> 4, i = rho & 15; return 8 * (i >> 2) + 4 * n + (i & 3); }
struct Unit { int pm, pn, e; const LAS unsigned char* meta; };
__device__ __forceinline__ unsigned cvt_pk_bf16(float lo, float hi) { unsigned r; asm volatile("v_cvt_pk_bf16_f32 %0, %1, %2" : "=v"(r) : "v"(lo), "v"(hi)); return r; }

template <class Epi, class Sched, bool ALIGN_EPI, bool F8 = false>
__device__ __forceinline__ void gemm_phase(LAS unsigned char* lds, const int K, const Sched& S, const Epi& E) {
    const int tid = threadIdx.x, wid = __builtin_amdgcn_readfirstlane(tid >> 6), lane = tid & 63, wr = wid >> 2, wc = wid & 3, fr = lane & 15, fq = lane >> 4;
    const int nt = K / BK;
    int Rr[2], Cc[2]; unsigned voffB[2];
#pragma unroll
    for (int i = 0; i < 2; ++i) { stage_rc(tid * 16 + i * 8192, Rr[i], Cc[i]); const int R = Rr[i];
        const int Rb = (int)Epi::PERM == 1 ? ((R & ~31) + perm32(R & 31)) : (int)Epi::PERM == 2 ? (64 * (R >> 5) + 16 * ((R >> 2) & 3) + 4 * ((R >> 4) & 1) + (R & 3)) : R;
        voffB[i] = (unsigned)(Rb * K + Cc[i]) * 2u; }
    const size_t kstep = (size_t)(BK * 2);
    const size_t hstep = (size_t)((int)Epi::PERM == 2 ? 8 : HALF) * K * 2;
    const unsigned ldsw = (unsigned)wid * 1024u;
    const int aoff = lds_byte(wr * 64 + fr, fq * 8), boff = lds_byte(wc * 32 + fr, fq * 8);
#define PG8_SA(b, h) (((b) * 2 + (h)) * HTB)
#define PG8_SB(b, h) ((4 + (b) * 2 + (h)) * HTB)
#define PG8_STAGE(bufoff, gbase, voff) do { const char* gb_ = (const char*)(gbase); asm volatile("" : "+s"(gb_));     \
        _Pragma("unroll") for (int _i = 0; _i < 2; ++_i) \
        __builtin_amdgcn_global_load_lds((const unsigned*)(gb_ + (voff)[_i]), (LAS unsigned*)(lds + (bufoff) + ldsw + _i * 8192), 16, 0, 0); } while (0)
#define PG8_LDA(dst, b, h) do { _Pragma("unroll") for (int m = 0; m < 4; ++m) _Pragma("unroll") for (int k = 0; k < 2; ++k) dst[m][k] = *(const LAS bf16x8*)(lds + PG8_SA(b, h) + aoff + m * 2048 + k * 1024); } while (0)
#define PG8_LDB(dst, b, h) do { _Pragma("unroll") for (int n = 0; n < 2; ++n) _Pragma("unroll") for (int k = 0; k < 2; ++k) dst[n][k] = *(const LAS bf16x8*)(lds + PG8_SB(b, h) + boff + n * 2048 + k * 1024); } while (0)
#define PG8_MMA(ai, bj, At, Bt) do { __builtin_amdgcn_s_setprio(1); _Pragma("unroll") for (int m = 0; m < 4; ++m) _Pragma("unroll") for (int n = 0; n < 2; ++n) { \
        if constexpr (F8) { typedef int i32x8_ __attribute__((ext_vector_type(8))); typedef int i32x4_ __attribute__((ext_vector_type(4))); \
            const i32x4_ a0_ = __builtin_bit_cast(i32x4_, At[m][0]), a1_ = __builtin_bit_cast(i32x4_, At[m][1]), b0_ = __builtin_bit_cast(i32x4_, Bt[n][0]), b1_ = __builtin_bit_cast(i32x4_, Bt[n][1]); \
            const i32x8_ av_ = {a0_[0], a0_[1], a0_[2], a0_[3], a1_[0], a1_[1], a1_[2], a1_[3]}, bv_ = {b0_[0], b0_[1], b0_[2], b0_[3], b1_[0], b1_[1], b1_[2], b1_[3]}; \
            acc[ai][bj][m][n] = __builtin_amdgcn_mfma_scale_f32_16x16x128_f8f6f4(bv_, av_, acc[ai][bj][m][n], 0, 0, 0, 0x7f7f7f7f, 0, 0x7f7f7f7f); }     \
        else { _Pragma("unroll") for (int k = 0; k < 2; ++k) acc[ai][bj][m][n] = __builtin_amdgcn_mfma_f32_16x16x32_bf16(Bt[n][k], At[m][k], acc[ai][bj][m][n], 0, 0, 0); } } \
        __builtin_amdgcn_s_setprio(0); } while (0)
#define PG8_WAIT_V(n) asm volatile("s_waitcnt vmcnt(" #n ")" ::: "memory")
#define PG8_WAIT_VR(relax) do { if (relax) asm volatile("s_waitcnt vmcnt(%0)" :: "n"(8 + Epi::NSTORE) : "memory"); else asm volatile("s_waitcnt vmcnt(8)" ::: "memory"); } while (0)
#define PG8_WAIT_L(n) asm volatile("s_waitcnt lgkmcnt(" #n ")" ::: "memory")
#define PG8_BAR __builtin_amdgcn_s_barrier()
#define PG8_SCHED __builtin_amdgcn_sched_barrier(0)
#define PG8_LOADVO(dst, u) do { _Pragma("unroll") for (int _h = 0; _h < 2; ++_h) _Pragma("unroll") for (int _i = 0; _i < 2; ++_i) dst[_h][_i] = S.a_off(u, _h * HALF + Rr[_i]) + (unsigned)Cc[_i] * 2u; } while (0)
    Unit cur, nxt; int ui = 0;
    if (!S.next(0, cur)) return;
    f32x4 acc[2][2][4][2];
#pragma unroll
    for (int a = 0; a < 2; ++a)
#pragma unroll
        for (int b = 0; b < 2; ++b)
#pragma unroll
            for (int m = 0; m < 4; ++m)
#pragma unroll
                for (int n = 0; n < 2; ++n) acc[a][b][m][n] = (f32x4){0.f, 0.f, 0.f, 0.f};
    bf16x8 At[4][2], B0[2][2], B1[2][2];
    unsigned vo[2][2], nvo[2][2];
    PG8_LOADVO(vo, cur);
    const char* cA = S.a_ptr(cur); const char* cB = S.b_ptr(cur);
    LAS unsigned char* const metab = lds + 8 * HTB;
    cur.meta = metab;
    if constexpr (Sched::META != 0) S.meta_issue(cur, metab, wid, lane);
    PG8_STAGE(PG8_SB(0, 0), cB, voffB); PG8_STAGE(PG8_SB(0, 1), cB + hstep, voffB); PG8_STAGE(PG8_SA(0, 0), cA, vo[0]); PG8_STAGE(PG8_SA(0, 1), cA, vo[1]);
    if (wr == 1) PG8_BAR;
    PG8_WAIT_V(2); PG8_BAR;
    PG8_STAGE(PG8_SB(1, 0), cB + kstep, voffB); PG8_STAGE(PG8_SA(1, 0), cA + kstep, vo[0]); PG8_STAGE(PG8_SB(1, 1), cB + hstep + kstep, voffB);
    PG8_WAIT_V(6); PG8_BAR;
    for (;;) {
        const bool has_next = S.next(ui + 1, nxt);
        const char* nA = cA; const char* nB = cB;
        if (has_next) { nA = S.a_ptr(nxt); nB = S.b_ptr(nxt); nxt.meta = metab + ((ui + 1) % 3) * 2048;
            if constexpr (Sched::META != 0) S.meta_issue(nxt, (LAS unsigned char*)nxt.meta, wid, lane);
            else if constexpr (Sched::GATHER) { PG8_LOADVO(nvo, nxt); } }
#pragma nounroll
        for (int t = 0; t < nt; t += 2) {
            const bool last = (t == nt - 2);
            const char* a1 = cA + (size_t)(t + 1) * kstep;
            const char* a2 = last ? nA : cA + (size_t)(t + 2) * kstep; const char* b2 = last ? nB : cB + (size_t)(t + 2) * kstep;
            const char* a3 = a2 + kstep; const char* b3 = b2 + kstep;
            const bool relax = (t == 0) && (ui > 0);
            PG8_LDB(B0, 0, 0); PG8_LDB(B1, 0, 1); PG8_SCHED; PG8_LDA(At, 0, 0); PG8_STAGE(PG8_SA(1, 1), a1, vo[1]);
            if constexpr (Sched::GATHER) { if (last && has_next) {
#pragma unroll
                for (int _h = 0; _h < 2; ++_h)
#pragma unroll
                    for (int _i = 0; _i < 2; ++_i) { if constexpr (Sched::META != 0) { int R2_, C2_; int tid2_ = threadIdx.x; asm volatile("" : "+v"(tid2_)); stage_rc(tid2_ * 16 + _i * 8192, R2_, C2_);
                            vo[_h][_i] = S.meta_off(nxt.meta, _h * HALF + R2_) + (unsigned)C2_ * 2u; } else vo[_h][_i] = nvo[_h][_i]; } } }
            PG8_WAIT_VR(relax); PG8_WAIT_L(0); PG8_BAR; PG8_MMA(0, 0, At, B0); PG8_MMA(0, 1, At, B1); PG8_BAR; PG8_SCHED;
            PG8_LDA(At, 0, 1); PG8_STAGE(PG8_SB(0, 0), b2, voffB); PG8_STAGE(PG8_SB(0, 1), b2 + hstep, voffB); PG8_STAGE(PG8_SA(0, 0), a2, vo[0]);
            PG8_WAIT_VR(relax); PG8_WAIT_L(0); PG8_BAR; PG8_MMA(1, 0, At, B0); PG8_MMA(1, 1, At, B1); PG8_BAR; PG8_SCHED;
            PG8_LDB(B0, 1, 0); PG8_LDB(B1, 1, 1); PG8_SCHED; PG8_LDA(At, 1, 0); PG8_STAGE(PG8_SA(0, 1), a2, vo[1]);
            PG8_WAIT_V(8); PG8_WAIT_L(0); PG8_BAR; PG8_MMA(0, 0, At, B0); PG8_MMA(0, 1, At, B1); PG8_BAR; PG8_SCHED;
            PG8_LDA(At, 1, 1); PG8_STAGE(PG8_SB(1, 0), b3, voffB); PG8_STAGE(PG8_SB(1, 1), b3 + hstep, voffB); PG8_STAGE(PG8_SA(1, 0), a3, vo[0]);
            PG8_WAIT_V(8); PG8_WAIT_L(0); PG8_BAR; PG8_MMA(1, 0, At, B0); PG8_MMA(1, 1, At, B1); PG8_BAR; PG8_SCHED;
        }
        if constexpr (ALIGN_EPI) { if (wr == 0) PG8_BAR; }
        E(acc, cur, wr, wc, fr, fq);
        if (!has_next) break;
#pragma unroll
        for (int a = 0; a < 2; ++a)
#pragma unroll
            for (int b = 0; b < 2; ++b)
#pragma unroll
                for (int m = 0; m < 4; ++m)
#pragma unroll
                    for (int n = 0; n < 2; ++n) acc[a][b][m][n] = (f32x4){0.f, 0.f, 0.f, 0.f};
        cur = nxt; cA = nA; cB = nB; ++ui;
        if constexpr (ALIGN_EPI) { if (wr == 1) PG8_BAR; }
    }
    PG8_WAIT_V(0);
    if constexpr (!ALIGN_EPI) { if (wr == 0) PG8_BAR; }
    PG8_BAR;
#undef PG8_SA
#undef PG8_SB
#undef PG8_STAGE
#undef PG8_LDA
#undef PG8_LDB
#undef PG8_MMA
#undef PG8_WAIT_V
#undef PG8_WAIT_VR
#undef PG8_WAIT_L
#undef PG8_BAR
#undef PG8_SCHED
#undef PG8_LOADVO
}

struct DenseSched {
    static constexpr bool GATHER = false; static constexpr int META = 0;
    const char* A; const char* Bt; int K; int nM, nN, nwg, G, c, i_lo, i_hi;
    __device__ __forceinline__ void init(const void* A_, const void* Bt_, int M, int N, int K_, int G_, int c_) { A = (const char*)A_; Bt = (const char*)Bt_; K = K_; nM = M / BM; nN = N / BM; nwg = nM * nN; G = G_; c = c_; i_lo = 0; i_hi = 1 << 30; }
    __device__ __forceinline__ bool next(int i, Unit& u) const {
        i += i_lo; if (i >= i_hi) return false;
        const long L = (long)i * G + c; if (L >= nwg) return false;
        int wgid = (int)L; { const int q = nwg / NXCD, r = nwg % NXCD, xcd = wgid % NXCD, off = wgid / NXCD; wgid = (xcd < r ? xcd * (q + 1) : r * (q + 1) + (xcd - r) * q) + off; }
        const int nig = WGM * nN, gid = wgid / nig, fm = gid * WGM, gsz = (nM - fm) < WGM ? (nM - fm) : WGM;
        u.pm = fm + ((wgid % nig) % gsz); u.pn = (wgid % nig) / gsz; u.e = 0; return true;
    }
    __device__ __forceinline__ const char* a_ptr(const Unit& u) const { return A + (size_t)u.pm * BM * K * 2; }
    __device__ __forceinline__ const char* b_ptr(const Unit& u) const { return Bt + (size_t)u.pn * BM * K * 2; }
    __device__ __forceinline__ unsigned a_off(const Unit&, int row) const { return (unsigned)(row * K) * 2u; }
};
}

__device__ __forceinline__ void tr_item(const float* W, int K, int N, bf16* WT, int k0, int n0, int rb, LAS float* scr, int lane) {
#pragma unroll 8
    for (int i = 0; i < 32; ++i) { const int kk = 2 * i + (lane >> 5); scr[kk * 33 + (lane & 31)] = W[(size_t)(k0 + kk) * N + n0 + (lane & 31)]; }
    LDS_WAIT(); asm volatile("" ::: "memory");
    const int c = lane & 7;
#pragma unroll
    for (int j = 0; j < 4; ++j) { const int n = (lane >> 3) + 8 * j; const LAS float* s = scr + (8 * c) * 33 + n;
        u32x4 o; o.x = pk2(s[0 * 33], s[1 * 33]); o.y = pk2(s[2 * 33], s[3 * 33]); o.z = pk2(s[4 * 33], s[5 * 33]); o.w = pk2(s[6 * 33], s[7 * 33]);
        *(u32x4*)(WT + (size_t)(rb + n) * K + k0 + 8 * c) = o; }
    LDS_WAIT(); asm volatile("" ::: "memory");
}
__device__ __forceinline__ void tr_dense(const float* W, int K, int N, bf16* WT, int item, LAS float* scr, int lane) {
    const int nblk = N / 32, kb = item / nblk, nb = item % nblk;
    tr_item(W, K, N, WT, 64 * kb, 32 * nb, 32 * nb, scr, lane);
}
__device__ __forceinline__ void tr_expert(const Ctx& F, int e, int r, LAS float* scr) {
    const float* wg = (e < NE) ? F.in(16) + (size_t)e * DM * EDIM : F.in(19);
    const float* wu = (e < NE) ? F.in(17) + (size_t)e * DM * EDIM : F.in(20);
    const float* wd = (e < NE) ? F.in(18) + (size_t)e * EDIM * DM : F.in(21);
    bf16* gu = (bf16*)(F.ws + WS_WGU) + (size_t)e * 512 * 1024;
    bf16* dd = (bf16*)(F.ws + WS_WD) + (size_t)e * 1024 * 256;
    if (r < 256) {
        const int up = r >> 7, it = r & 127, kb = it >> 3, nb = it & 7, n0 = 32 * nb;
        const int rb = (n0 >> 7) * 256 + up * 128 + (n0 & 127);
        tr_item(up ? wu : wg, DM, EDIM, gu, 64 * kb, n0, rb, scr, F.lane);
    } else {
        const int it = r - 256, kb = it >> 5, nb = it & 31;
        tr_item(wd, EDIM, DM, dd, 64 * kb, 32 * nb, 32 * nb, scr, F.lane);
    }
}

constexpr int N_GU_ITEMS = 257 * 128, N_D_ITEMS = 257 * 64;
constexpr int CVT_G1 = 12 * 2048, CVT_D1 = 4 * 2048;
struct CvtItem { const float* W; bf16* WT; int N, K, k0, n0, rb; };
struct CvtBases { const float *g, *u, *d, *gs, *us, *ds; };
__device__ __forceinline__ CvtBases cvt_bases(const Ctx& F) { CvtBases b; b.g = F.in(16); b.u = F.in(17); b.d = F.in(18); b.gs = F.in(19); b.us = F.in(20); b.ds = F.in(21); return b; }
template <bool GU> __device__ __forceinline__ CvtItem cvt_decode(const Ctx& F, const CvtBases& P, int item) {
    CvtItem c;
    if (GU) {
        const int e = item / 128, r = item % 128;
        const int up = r >> 6, kb = (r & 63) >> 2, nb = r & 3, n0 = 64 * nb;
        c.W = up ? ((e < NE) ? P.u + (size_t)e * DM * EDIM : P.us) : ((e < NE) ? P.g + (size_t)e * DM * EDIM : P.gs);
        c.WT = MOE1_FP8 ? (bf16*)((unsigned char*)(F.ws + WS_WGU) + (size_t)e * 512 * 1024) : (bf16*)(F.ws + WS_WGU) + (size_t)e * 512 * 1024;
        c.N = EDIM; c.K = DM; c.k0 = 64 * kb; c.n0 = n0; c.rb = (n0 >> 7) * 256 + up * 128 + (n0 & 127);
    } else {
        const int e = item / 64, it = item % 64, kb = it >> 4, nb = it & 15;
        c.W = (e < NE) ? P.d + (size_t)e * EDIM * DM : P.ds; c.WT = MOE2_FP8 ? (bf16*)((unsigned char*)(F.ws + WS_WD) + (size_t)e * 1024 * 256) : (bf16*)(F.ws + WS_WD) + (size_t)e * 1024 * 256; c.N = DM; c.K = EDIM; c.k0 = 64 * kb; c.n0 = 64 * nb; c.rb = 64 * nb;
    }
    return c;
}
template <bool NT = true, bool F8 = false> __device__ __forceinline__ void cvt_load(const CvtItem& c, f32x4 (&v)[16], int lane) {
    const float* p = c.W + (size_t)(c.k0 + (F8 ? 2 : 1) * (lane >> 4)) * c.N + c.n0 + 4 * (lane & 15);
#pragma unroll
    for (int i = 0; i < 16; ++i) { const int ro = F8 ? 8 * (i >> 1) + (i & 1) : 4 * i; v[i] = NT ? __builtin_nontemporal_load((const f32x4*)(p + (size_t)ro * c.N)) : *(const f32x4*)(p + (size_t)ro * c.N); }
}
template <bool NT = true> __device__ __forceinline__ void cvt_store_f8(const CvtItem& c, const f32x4 (&v)[16], LAS unsigned char* img, int lane) {
    const int kp = lane >> 4, n4 = 4 * (lane & 15);
    LAS unsigned char* wp = img + (n4 >> 5) * 2048 + kp * 64 + (n4 & 31) * 2;
#pragma unroll
    for (int i = 0; i < 8; ++i) { const f32x4 a = v[2 * i] * W8_SCALE, b = v[2 * i + 1] * W8_SCALE; int t0 = 0, t1 = 0;
        t0 = __builtin_amdgcn_cvt_pk_fp8_f32(a.x, b.x, t0, false); t0 = __builtin_amdgcn_cvt_pk_fp8_f32(a.y, b.y, t0, true);
        t1 = __builtin_amdgcn_cvt_pk_fp8_f32(a.z, b.z, t1, false); t1 = __builtin_amdgcn_cvt_pk_fp8_f32(a.w, b.w, t1, true);
        *(LAS u32x2*)(wp + i * 256) = (u32x2){(unsigned)t0, (unsigned)t1}; }
    LDS_WAIT(); asm volatile("" ::: "memory");
    const int g = lane >> 4, q = (lane & 15) >> 2, p = lane & 3, i16 = lane & 15;
    unsigned char* wt = (unsigned char*)c.WT;
#pragma unroll
    for (int s = 0; s < 4; ++s) {
        const LAS unsigned char* rp = img + (s >> 1) * 2048 + (8 * g + q) * 64 + (16 * (s & 1) + 4 * p) * 2;
        const s16x4 lo = vtr(rp), hh = vtr(rp + 256);
        const u32x4 o = __builtin_bit_cast(u32x4, (bf16x8){lo[0], lo[1], lo[2], lo[3], hh[0], hh[1], hh[2], hh[3]});
        if (NT) __builtin_nontemporal_store(o, (u32x4*)(wt + (size_t)(c.rb + 16 * s + i16) * c.K + c.k0 + 16 * g)); else *(u32x4*)(wt + (size_t)(c.rb + 16 * s + i16) * c.K + c.k0 + 16 * g) = o;
    }
    LDS_WAIT(); asm volatile("" ::: "memory");
}
template <bool NT = true> __device__ __forceinline__ void cvt_store(const CvtItem& c, const f32x4 (&v)[16], LAS unsigned char* img, int lane) {
    const int kk0 = lane >> 4, n4 = 4 * (lane & 15);
    LAS unsigned char* wp = img + (n4 >> 5) * 4096 + kk0 * 64 + (n4 & 31) * 2;
#pragma unroll
    for (int i = 0; i < 16; ++i) { u32x2 w; w.x = pk2(v[i].x, v[i].y); w.y = pk2(v[i].z, v[i].w); *(LAS u32x2*)(wp + i * 256) = w; }
    LDS_WAIT(); asm volatile("" ::: "memory");
    const int g = lane >> 4, q = (lane & 15) >> 2, p = lane & 3, i16 = lane & 15;
#pragma unroll
    for (int s = 0; s < 8; ++s) {
        const int oct = 4 * (s & 1) + g, cb = s >> 1;
        const LAS unsigned char* rp = img + (cb >> 1) * 4096 + (8 * oct + q) * 64 + (16 * (cb & 1) + 4 * p) * 2;
        const s16x4 lo = vtr(rp), hh = vtr(rp + 256);
        u32x4 o = __builtin_bit_cast(u32x4, (bf16x8){lo[0], lo[1], lo[2], lo[3], hh[0], hh[1], hh[2], hh[3]});
        if (NT) __builtin_nontemporal_store(o, (u32x4*)(c.WT + (size_t)(c.rb + 16 * cb + i16) * c.K + c.k0 + 8 * oct)); else *(u32x4*)(c.WT + (size_t)(c.rb + 16 * cb + i16) * c.K + c.k0 + 8 * oct) = o;
    }
    LDS_WAIT(); asm volatile("" ::: "memory");
}
template <bool GU> __device__ __forceinline__ void cvt_experts(const Ctx& F, LAS unsigned char* img, const int item_lo, const int item_hi) {
    constexpr bool F8 = GU ? (bool)MOE1_FP8 : (bool)MOE2_FP8;
    const int NGW = F.G * NWAVES; int it = item_lo + F.blk * NWAVES + F.wave;
    if (it >= item_hi) return;
    f32x4 va[16], vb[16];
    const CvtBases P = cvt_bases(F);
    CvtItem ca = cvt_decode<GU>(F, P, it), cb;
    cvt_load<true, F8>(ca, va, F.lane);
    for (;;) {
        const int it1 = it + NGW, it1c = it1 < item_hi ? it1 : it;
        cb = cvt_decode<GU>(F, P, it1c); cvt_load<true, F8>(cb, vb, F.lane);
        if (F8) cvt_store_f8(ca, va, img, F.lane); else cvt_store(ca, va, img, F.lane);
        if (it1 >= item_hi) break;
        const int it2 = it1 + NGW, it2c = it2 < item_hi ? it2 : it1;
        ca = cvt_decode<GU>(F, P, it2c); cvt_load<true, F8>(ca, va, F.lane);
        if (F8) cvt_store_f8(cb, vb, img, F.lane); else cvt_store(cb, vb, img, F.lane);
        if (it2 >= item_hi) break;
        it = it2;
    }
}
__device__ __forceinline__ void phase_prologue(const Ctx& F) { const float* const p_c = F.in(1); const float* const p_wada = F.in(2); const float* const p_bada = F.in(3); const float* const p_win = F.in(6); const float* const p_wba = F.in(9); const float* const p_wbb = F.in(10); const float* const p_wout = F.in(11); const float* const p_wr = F.in(14);
    {
        LAS float* sc = (LAS float*)(F.lds + 69632);
        LAS float* red = (LAS float*)(F.lds);
        float* mod = (float*)(F.ws + WS_MOD);
        for (int it = F.blk; it < 96; it += F.G) {
            __syncthreads();
            for (int i = F.tid; i < 16 * 1024; i += NTHR) { const float v = p_c[i]; sc[i] = v * sigmoidf_(v); }
            __syncthreads();
            const int col = it * 64 + F.lane, kb = F.wave * 128;
            float acc[16];
#pragma unroll
            for (int b = 0; b < 16; ++b) acc[b] = 0.f;
            for (int k = 0; k < 128; k += 4) {
                float w0 = p_wada[(size_t)(kb + k) * 6144 + col], w1 = p_wada[(size_t)(kb + k + 1) * 6144 + col], w2 = p_wada[(size_t)(kb + k + 2) * 6144 + col], w3 = p_wada[(size_t)(kb + k + 3) * 6144 + col];
#pragma unroll
                for (int b = 0; b < 16; ++b) { const f32x4 s = *(const LAS f32x4*)(sc + b * 1024 + kb + k); acc[b] += s.x * w0 + s.y * w1 + s.z * w2 + s.w * w3; }
            }
#pragma unroll
            for (int b = 0; b < 16; ++b) red[(F.wave * 16 + b) * 64 + F.lane] = acc[b];
            __syncthreads();
            for (int o = F.tid; o < 1024; o += NTHR) { const int b = o >> 6, l = o & 63; float s = 0.f;
#pragma unroll
                for (int w = 0; w < 8; ++w) s += red[(w * 16 + b) * 64 + l];
                mod[b * 6144 + it * 64 + l] = s + p_bada[it * 64 + l]; }
        }
        __syncthreads();
    }
    const int gw = F.blk * NWAVES + F.wave, NGW = F.G * NWAVES;
    constexpr int D_IN = 16 * 68, D_A = 8 * 16, D_OUT = 16 * 16, D_R = 16 * 4;
    constexpr int NDENSE = D_IN + 2 * D_A + D_OUT + D_R;
    for (int it = gw; it < NDENSE; it += NGW) {
        int r = it; CvtItem c;
        if (r < D_IN) { c.W = p_win; c.WT = (bf16*)(F.ws + WS_WIN); c.N = INW; c.K = DM; c.k0 = 64 * (r / 68); c.n0 = 64 * (r % 68); }
        else if ((r -= D_IN) < D_A) { c.W = p_wba; c.WT = (bf16*)(F.ws + WS_WA); c.N = DM; c.K = 512; c.k0 = 64 * (r / 16); c.n0 = 64 * (r % 16); }
        else if ((r -= D_A) < D_A) { c.W = p_wbb; c.WT = (bf16*)(F.ws + WS_WB); c.N = DM; c.K = 512; c.k0 = 64 * (r / 16); c.n0 = 64 * (r % 16); }
        else if ((r -= D_A) < D_OUT) { c.W = p_wout; c.WT = (bf16*)(F.ws + WS_WOUT); c.N = DM; c.K = DM; c.k0 = 64 * (r / 16); c.n0 = 64 * (r % 16); }
        else { r -= D_OUT; c.W = p_wr; c.WT = (bf16*)(F.ws + WS_WR); c.N = NE; c.K = DM; c.k0 = 64 * (r / 4); c.n0 = 64 * (r % 4); }
        c.rb = c.n0;
        const bool f8 = (F8G && it >= 16 * 36 && it < D_IN) || (F8B && it >= D_IN && it < D_IN + 2 * D_A) || (F8O && it >= D_IN + 2 * D_A && it < D_IN + 2 * D_A + D_OUT);
        if (F8G && it < D_IN) { c.k0 = 64 * (it % 16); c.n0 = 64 * (it / 16); c.rb = c.n0; if (f8) { c.WT = (bf16*)(F.ws + WS_WIN8); c.rb = c.n0 - C_GA; } }
        f32x4 v[16];
        if (f8) { cvt_load<false, true>(c, v, F.lane); cvt_store_f8<false>(c, v, F.lds + F.wave * 8448, F.lane); }
        else { cvt_load<false>(c, v, F.lane); cvt_store<false>(c, v, F.lds + F.wave * 8448, F.lane); }
    }
    if (NEW_CVT && CVT_IN_P0) { cvt_experts<true>(F, F.lds + F.wave * 8448, 0, N_GU_ITEMS); cvt_experts<false>(F, F.lds + F.wave * 8448, 0, N_D_ITEMS); }
}

__device__ __forceinline__ void phase_h(const Ctx& F) { const float* const p_x = F.in(0); const float* const p_gpm = F.in(4);
    const int gw = F.blk * NWAVES + F.wave, NGW = F.G * NWAVES;
    const float* mod = (const float*)(F.ws + WS_MOD);
    bf16* h = (bf16*)(F.ws + WS_A1);
    for (int ch = gw; ch < T / 16; ch += NGW) {
        const int row0 = ch * 16, b = row0 / SEQ;
        f32x4 gs[4], sh[4];
#pragma unroll
        for (int j = 0; j < 4; ++j) { const int col = 4 * F.lane + 256 * j;
            const f32x4 g = *(const f32x4*)(p_gpm + col), s1 = *(const f32x4*)(mod + b * 6144 + 1024 + col);
            gs[j] = g * (s1 + 1.0f); sh[j] = *(const f32x4*)(mod + b * 6144 + col); }
        for (int rr = 0; rr < 16; ++rr) {
            const float* xr = p_x + (size_t)(row0 + rr) * DM;
            f32x4 v[4]; float s = 0.f;
#pragma unroll
            for (int j = 0; j < 4; ++j) { v[j] = *(const f32x4*)(xr + 4 * F.lane + 256 * j); s += (v[j].x * v[j].x + v[j].y * v[j].y) + (v[j].z * v[j].z + v[j].w * v[j].w); }
            const float rinv = 1.0f / sqrtf(wave_sum(s) * (1.f / DM) + RMS_EPS);
            bf16* orow = h + (size_t)(row0 + rr) * DM;
#pragma unroll
            for (int j = 0; j < 4; ++j) { const f32x4 o = v[j] * rinv * gs[j] + sh[j]; u32x2 w; w.x = pk2(o.x, o.y); w.y = pk2(o.z, o.w); *(u32x2*)(orow + 4 * F.lane + 256 * j) = w;
                if (F8G) { int t8 = 0; t8 = __builtin_amdgcn_cvt_pk_fp8_f32(o.x, o.y, t8, false); t8 = __builtin_amdgcn_cvt_pk_fp8_f32(o.z, o.w, t8, true); *(unsigned*)(F.ws + WS_A3 + (size_t)(row0 + rr) * DM + 4 * F.lane + 256 * j) = (unsigned)t8; } }
        }
    }
}

template <int MODE> __device__ __forceinline__ void phase_dense(const Ctx& F) {
    const bf16* A; const bf16* Bt; int K, N;
    if (MODE == 0) { A = (const bf16*)(F.ws + WS_A1); Bt = (const bf16*)(F.ws + WS_WIN); K = 1024; N = INW; }
    else if (MODE == 1) { A = (const bf16*)(F.ws + WS_A2); Bt = (const bf16*)(F.ws + WS_WA); K = 512; N = 1024; }
    else if (MODE == 2) { A = (const bf16*)(F.ws + WS_A2) + (size_t)T * 512; Bt = (const bf16*)(F.ws + WS_WB); K = 512; N = 1024; }
    else if (MODE == 3) { A = (const bf16*)(F.ws + WS_A3); Bt = (const bf16*)(F.ws + WS_WOUT); K = 1024; N = 1024; }
    else { A = (const bf16*)(F.ws + WS_A2); Bt = (const bf16*)(F.ws + WS_WR); K = 1024; N = 256; }
    const int nN = N / 256, nU = (T / 128) * nN;
    const int r32 = F.lane & 31, hi = F.lane >> 5, wm = F.wave >> 2, wn = F.wave & 3;
    const int prow = F.tid >> 3, pch = F.tid & 7;
    bf16* proj = (bf16*)(F.ws + WS_PROJ);
    for (int u = F.blk; u < nU; u += F.G) {
        const int pm = u / nN, pn = u % nN;
        const char* pa0 = (const char*)(A + (size_t)(pm * 128 + prow) * K) + pch * 16;
        const char* pa1 = pa0 + (size_t)64 * K * 2;
        const char* pb0 = (const char*)(Bt + (size_t)(pn * 256 + prow) * K) + pch * 16;
        const size_t bs = (size_t)64 * K * 2;
        f32x16 acc[2][2];
        sg_mainloop(F.lds, pa0, pa1, pb0, pb0 + bs, pb0 + 2 * bs, pb0 + 3 * bs, K, acc);
#pragma unroll
        for (int mt = 0; mt < 2; ++mt) {
            const size_t row = (size_t)pm * 128 + wm * 64 + mt * 32 + r32;
#pragma unroll
            for (int j = 0; j < 2; ++j)
#pragma unroll
                for (int rg = 0; rg < 4; ++rg) {
                    const int col = pn * 256 + j * 128 + wn * 32 + 8 * rg + 4 * hi;
                    float v0 = acc[mt][j][4 * rg], v1 = acc[mt][j][4 * rg + 1], v2 = acc[mt][j][4 * rg + 2], v3 = acc[mt][j][4 * rg + 3];
                    if (MODE == 0) { u32x2 w; w.x = pk2(v0, v1); w.y = pk2(v2, v3); *(u32x2*)(proj + row * INW + col) = w; }
                    else if (MODE == 1 || MODE == 2) {
                        const u32x2 g = *(const u32x2*)(proj + row * INW + (MODE == 1 ? C_GA : C_GB) + col);
                        v0 *= sigmoidf_(bflo(g.x)); v1 *= sigmoidf_(bfhi(g.x)); v2 *= sigmoidf_(bflo(g.y)); v3 *= sigmoidf_(bfhi(g.y));
                        bf16* mp = (bf16*)(F.ws + WS_A3) + row * DM + col;
                        if (MODE == 2) { const u32x2 m = *(const u32x2*)mp; v0 += bflo(m.x); v1 += bfhi(m.x); v2 += bflo(m.y); v3 += bfhi(m.y); }
                        u32x2 w; w.x = pk2(v0, v1); w.y = pk2(v2, v3); *(u32x2*)mp = w;
                    } else if (MODE == 3) { u32x2 w; w.x = pk2(v0, v1); w.y = pk2(v2, v3); *(u32x2*)((bf16*)(F.ws + WS_A1) + row * DM + col) = w; }
                    else { *(f32x4*)((float*)(F.ws + WS_A1) + row * NE + col) = (f32x4){v0, v1, v2, v3}; }
                }
        }
    }
}


namespace pg8 {
struct EpiStoreBf16 {
    static constexpr int PERM = 1, NSTORE = 16; bf16* O; int ldc; int coff; float scale;
    __device__ __forceinline__ void operator()(const f32x4 (&acc)[2][2][4][2], const Unit& u, int wr, int wc, int fr, int fq) const {
        const int row0 = u.pm * BM + wr * 64 + fr, col0 = coff + u.pn * BM + wc * 32 + 8 * fq;
#pragma unroll
        for (int ai = 0; ai < 2; ++ai)
#pragma unroll
            for (int m = 0; m < 4; ++m) { bf16* rowp = O + (size_t)(row0 + ai * HALF + m * 16) * ldc + col0;
#pragma unroll
                for (int bj = 0; bj < 2; ++bj) { const f32x4 v0 = acc[ai][bj][m][0] * scale, v1 = acc[ai][bj][m][1] * scale;
                    u32x4 w; w.x = cvt_pk_bf16(v0[0], v0[1]); w.y = cvt_pk_bf16(v0[2], v0[3]); w.z = cvt_pk_bf16(v1[0], v1[1]); w.w = cvt_pk_bf16(v1[2], v1[3]);
                    *(u32x4*)(rowp + bj * HALF) = w; } }
    }
};
template <bool ADD> struct EpiGate {
    static constexpr int PERM = 1, NSTORE = 16; const bf16* proj; int gcol; bf16* merged; float scale; unsigned char* m8;
    __device__ __forceinline__ void operator()(const f32x4 (&acc)[2][2][4][2], const Unit& u, int wr, int wc, int fr, int fq) const {
        const int row0 = u.pm * BM + wr * 64 + fr, col0 = u.pn * BM + wc * 32 + 8 * fq;
#pragma unroll
        for (int ai = 0; ai < 2; ++ai)
#pragma unroll
            for (int m = 0; m < 4; ++m) { const size_t row = (size_t)(row0 + ai * HALF + m * 16);
#pragma unroll
                for (int bj = 0; bj < 2; ++bj) { f32x4 v0 = acc[ai][bj][m][0] * scale, v1 = acc[ai][bj][m][1] * scale;
                    const u32x4 g = *(const u32x4*)(proj + row * INW + gcol + col0 + bj * HALF);
                    v0[0] *= sigmoidf_(bflo(g.x)); v0[1] *= sigmoidf_(bfhi(g.x)); v0[2] *= sigmoidf_(bflo(g.y)); v0[3] *= sigmoidf_(bfhi(g.y));
                    v1[0] *= sigmoidf_(bflo(g.z)); v1[1] *= sigmoidf_(bfhi(g.z)); v1[2] *= sigmoidf_(bflo(g.w)); v1[3] *= sigmoidf_(bfhi(g.w));
                    bf16* mp = merged + row * DM + col0 + bj * HALF;
                    if (ADD) { const u32x4 o = *(const u32x4*)mp; v0[0] += bflo(o.x); v0[1] += bfhi(o.x); v0[2] += bflo(o.y); v0[3] += bfhi(o.y); v1[0] += bflo(o.z); v1[1] += bfhi(o.z); v1[2] += bflo(o.w); v1[3] += bfhi(o.w); }
                    if (ADD && F8O) { v0 = v0 * MRG8_SCALE; v1 = v1 * MRG8_SCALE; int t0 = 0, t1 = 0;
                        t0 = __builtin_amdgcn_cvt_pk_fp8_f32(v0[0], v0[1], t0, false); t0 = __builtin_amdgcn_cvt_pk_fp8_f32(v0[2], v0[3], t0, true);
                        t1 = __builtin_amdgcn_cvt_pk_fp8_f32(v1[0], v1[1], t1, false); t1 = __builtin_amdgcn_cvt_pk_fp8_f32(v1[2], v1[3], t1, true);
                        *(u32x2*)(m8 + row * DM + col0 + bj * HALF) = (u32x2){(unsigned)t0, (unsigned)t1}; }
                    else { u32x4 w; w.x = cvt_pk_bf16(v0[0], v0[1]); w.y = cvt_pk_bf16(v0[2], v0[3]); w.z = cvt_pk_bf16(v1[0], v1[1]); w.w = cvt_pk_bf16(v1[2], v1[3]);
                        *(u32x4*)mp = w; } } }
    }
};
struct EpiF32 {
    static constexpr int PERM = 0, NSTORE = 32; float* C; int ldc;
    __device__ __forceinline__ void operator()(const f32x4 (&acc)[2][2][4][2], const Unit& u, int wr, int wc, int fr, int fq) const {
        const int row0 = u.pm * BM + wr * 64 + fr, col0 = u.pn * BM + wc * 32 + 4 * fq;
#pragma unroll
        for (int ai = 0; ai < 2; ++ai)
#pragma unroll
            for (int m = 0; m < 4; ++m) { float* rowp = C + (size_t)(row0 + ai * HALF + m * 16) * ldc + col0;
#pragma unroll
                for (int bj = 0; bj < 2; ++bj)
#pragma unroll
                    for (int n = 0; n < 2; ++n) *(f32x4*)(rowp + bj * HALF + n * 16) = acc[ai][bj][m][n]; }
    }
};
template <int STAGE> struct MoeSched {
    static constexpr bool GATHER = (STAGE == 1); static constexpr int META = STAGE;
    static constexpr bool F8 = (STAGE == 1) ? (bool)MOE1_FP8 : (bool)MOE2_FP8;
    static constexpr int NPN = (STAGE == 1) ? 2 : 4, K = (STAGE == 1) ? (F8 ? 512 : 1024) : (F8 ? 128 : 256);
    const int* tile_e; const int* tokp; const int* ypos; const float* wpad; const char* Abase; const char* Bbase; int nrt, nU, G, c;
    __device__ __forceinline__ void meta_issue(const Unit& u, LAS unsigned char* slot, int wid, int lane_) const {
        int lane; asm volatile("v_mbcnt_lo_u32_b32 %0, -1, 0\n\tv_mbcnt_hi_u32_b32 %0, -1, %0" : "=v"(lane));
        if (STAGE == 1) { if (wid == 0) __builtin_amdgcn_global_load_lds((const unsigned*)(tokp + u.pm * BM + 4 * lane), (LAS unsigned*)slot, 16, 0, 0); }
        else { if (wid == 0) __builtin_amdgcn_global_load_lds((const unsigned*)(ypos + u.pm * BM + 4 * lane), (LAS unsigned*)slot, 16, 0, 0);
               if (wid == 1) __builtin_amdgcn_global_load_lds((const unsigned*)(wpad + u.pm * BM + 4 * lane), (LAS unsigned*)(slot + 1024), 16, 0, 0); }
    }
    __device__ __forceinline__ unsigned meta_off(const LAS unsigned char* slot, int row) const { int tk = ((const LAS int*)slot)[row]; tk = tk < 0 ? 0 : tk; return (unsigned)tk * (unsigned)(K * 2); }
    __device__ __forceinline__ bool next(int i, Unit& u) const {
        const long L = (long)i * G + c; if (L >= nU) return false;
        int id = (int)L; { const int q = nU / NXCD, r = nU % NXCD, xcd = id % NXCD, off = id / NXCD; id = (xcd < r ? xcd * (q + 1) : r * (q + 1) + (xcd - r) * q) + off; }
        const int tq = id / NPN; u.pn = id % NPN; u.pm = tq < nrt ? tq : SH_TILE0 + (tq - nrt); { int ev; const int* tp = tile_e + u.pm; asm volatile("s_load_dword %0, %1, 0x0\n\ts_waitcnt lgkmcnt(0)" : "=s"(ev) : "s"(tp) : "memory"); u.e = ev; } return true;
    }
    __device__ __forceinline__ const char* a_ptr(const Unit& u) const { return STAGE == 1 ? Abase : Abase + (size_t)u.pm * BM * K * 2; }
    __device__ __forceinline__ const char* b_ptr(const Unit& u) const { return Bbase + ((size_t)u.e * (NPN * BM) + (size_t)u.pn * BM) * K * 2; }
    __device__ __forceinline__ unsigned a_off(const Unit& u, int row) const {
        if (STAGE == 1) { int tk = tokp[u.pm * BM + row]; tk = tk < 0 ? 0 : tk; return (unsigned)tk * (unsigned)(K * 2); }
        return (unsigned)(row * K) * 2u;
    }
};
struct EpiHid {
    static constexpr int PERM = 1, NSTORE = 8; static constexpr float unscale = MOE1_FP8 ? 1.0f / W8_SCALE : 1.0f; bf16* hid;
    __device__ __forceinline__ void operator()(const f32x4 (&acc)[2][2][4][2], const Unit& u, int wr, int wc, int fr, int fq) const {
        const int row0 = u.pm * BM + wr * 64 + fr, col0 = u.pn * HALF + wc * 32 + 8 * fq;
#pragma unroll
        for (int ai = 0; ai < 2; ++ai)
#pragma unroll
            for (int m = 0; m < 4; ++m) { float hv[8];
#pragma unroll
                for (int n = 0; n < 2; ++n)
#pragma unroll
                    for (int q = 0; q < 4; ++q) { const float gt = acc[ai][0][m][n][q] * unscale, up = acc[ai][1][m][n][q] * unscale; hv[4 * n + q] = gt * sigmoidf_(gt) * up; }
                if (MOE2_FP8) { int t0 = 0, t1 = 0;
                    t0 = __builtin_amdgcn_cvt_pk_fp8_f32(hv[0] * HID8_SCALE, hv[1] * HID8_SCALE, t0, false); t0 = __builtin_amdgcn_cvt_pk_fp8_f32(hv[2] * HID8_SCALE, hv[3] * HID8_SCALE, t0, true);
                    t1 = __builtin_amdgcn_cvt_pk_fp8_f32(hv[4] * HID8_SCALE, hv[5] * HID8_SCALE, t1, false); t1 = __builtin_amdgcn_cvt_pk_fp8_f32(hv[6] * HID8_SCALE, hv[7] * HID8_SCALE, t1, true);
                    *(u32x2*)((unsigned char*)hid + (size_t)(row0 + ai * HALF + m * 16) * EDIM + col0) = (u32x2){(unsigned)t0, (unsigned)t1}; }
                else { u32x4 w; w.x = cvt_pk_bf16(hv[0], hv[1]); w.y = cvt_pk_bf16(hv[2], hv[3]); w.z = cvt_pk_bf16(hv[4], hv[5]); w.w = cvt_pk_bf16(hv[6], hv[7]);
                    *(u32x4*)(hid + (size_t)(row0 + ai * HALF + m * 16) * EDIM + col0) = w; } }
    }
};
struct EpiY {
    static constexpr int PERM = 2, NSTORE = 8; unsigned char* Y;
    __device__ __forceinline__ void operator()(const f32x4 (&acc)[2][2][4][2], const Unit& u, int wr, int wc, int fr, int fq) const {
        const int col0 = u.pn * BM + wc * 64 + 16 * fq;
#pragma unroll
        for (int ai = 0; ai < 2; ++ai)
#pragma unroll
            for (int m = 0; m < 4; ++m) { const int rl = wr * 64 + fr + ai * HALF + m * 16;
                const int yp = ((const LAS int*)u.meta)[rl]; const float wv = ((const LAS float*)(u.meta + 1024))[rl] * (MOE2_FP8 ? Y8_SCALE / (W8_SCALE * HID8_SCALE) : Y8_SCALE);
                const size_t yrow = yp >= 0 ? (size_t)yp : (size_t)(NASSIGN + T); u32x4 w;
#pragma unroll
                for (int bj = 0; bj < 2; ++bj)
#pragma unroll
                    for (int n = 0; n < 2; ++n) { const f32x4 v = acc[ai][bj][m][n] * wv; int t = 0;
                        t = __builtin_amdgcn_cvt_pk_fp8_f32(v[0], v[1], t, false); t = __builtin_amdgcn_cvt_pk_fp8_f32(v[2], v[3], t, true); w[2 * bj + n] = (unsigned)t; }
                *(u32x4*)(Y + yrow * DM + col0) = w; }
    }
};
}

template <int MODE> __device__ __forceinline__ void phase_dense_fast(const Ctx& F) {
    pg8::DenseSched S; constexpr bool F8 = (MODE == 1 || MODE == 2) ? (bool)F8B : (MODE == 3) ? (bool)F8O : false;
    if (MODE == 0) {
        const int grp = (F.blk >> 3) & 7;
        pg8::EpiStoreBf16 E{(bf16*)(F.ws + WS_PROJ), INW, 0, 1.0f};
        S.init(F.ws + WS_A1, F.ws + WS_WIN, T, F8G ? C_GA : INW, 1024, F.G, F.blk);
        const bool spread = NEW_CVT && !CVT_IN_P0;
        const int split = !spread ? 0 : F8G ? (grp < 2 ? 0 : grp < 4 ? 2 : 1 << 30) : grp;
        S.i_lo = 0; S.i_hi = split; pg8::gemm_phase<pg8::EpiStoreBf16, pg8::DenseSched, true>(F.lds, 1024, S, E);
        if (spread && (!F8G || grp < 4)) { cvt_experts<true>(F, F.lds + F.wave * 8448, 0, CVT_G1); __syncthreads(); }
        S.i_lo = split; S.i_hi = 1 << 30; pg8::gemm_phase<pg8::EpiStoreBf16, pg8::DenseSched, true>(F.lds, 1024, S, E);
        if (F8G) {
            pg8::DenseSched S8; S8.init(F.ws + WS_A3, F.ws + WS_WIN8, T, INW - C_GA, 512, F.G, F.blk);
            pg8::EpiStoreBf16 E8{(bf16*)(F.ws + WS_PROJ), INW, C_GA, 1.0f / W8_SCALE};
            const int split8 = !spread ? 0 : (grp < 6 ? 0 : 2);
            if (spread && grp >= 4 && grp < 6) { cvt_experts<true>(F, F.lds + F.wave * 8448, 0, CVT_G1); __syncthreads(); }
            S8.i_lo = 0; S8.i_hi = split8; pg8::gemm_phase<pg8::EpiStoreBf16, pg8::DenseSched, true, true>(F.lds, 512, S8, E8);
            if (spread && grp >= 6) { cvt_experts<true>(F, F.lds + F.wave * 8448, 0, CVT_G1); __syncthreads(); }
            S8.i_lo = split8; S8.i_hi = 1 << 30; pg8::gemm_phase<pg8::EpiStoreBf16, pg8::DenseSched, true, true>(F.lds, 512, S8, E8);
        }
    }
    else if (MODE == 1) { S.init(F.ws + WS_A2, F.ws + WS_WA, T, DM, F8 ? 256 : 512, F.G, F.blk); pg8::EpiGate<false> E{(const bf16*)(F.ws + WS_PROJ), C_GA, (bf16*)(F.ws + WS_A3), F8 ? 1.0f / (W8_SCALE * ATT8_SCALE) : 1.0f, nullptr};
        pg8::gemm_phase<pg8::EpiGate<false>, pg8::DenseSched, true, F8>(F.lds, F8 ? 256 : 512, S, E); }
    else if (MODE == 2) { S.init(F.ws + WS_A2 + (size_t)T * (F8 ? 512 : 1024), F.ws + WS_WB, T, DM, F8 ? 256 : 512, F.G, F.blk);
        pg8::EpiGate<true> E{(const bf16*)(F.ws + WS_PROJ), C_GB, (bf16*)(F.ws + WS_A3), F8 ? 1.0f / (W8_SCALE * ATT8_SCALE) : 1.0f, (unsigned char*)(F.ws + WS_A1)};
        pg8::gemm_phase<pg8::EpiGate<true>, pg8::DenseSched, true, F8>(F.lds, F8 ? 256 : 512, S, E); }
    else if (MODE == 3) { S.init(F.ws + (F8 ? WS_A1 : WS_A3), F.ws + WS_WOUT, T, DM, F8 ? 512 : 1024, F.G, F.blk);
        pg8::EpiStoreBf16 E{(bf16*)(F.ws + (F8 ? WS_A3 : WS_A1)), DM, 0, F8 ? 1.0f / (W8_SCALE * MRG8_SCALE) : 1.0f};
        pg8::gemm_phase<pg8::EpiStoreBf16, pg8::DenseSched, true, F8>(F.lds, F8 ? 512 : 1024, S, E); }
    else { S.init(F.ws + WS_A2, F.ws + WS_WR, T, NE, 1024, F.G, F.blk); pg8::EpiF32 E{(float*)(F.ws + WS_A1), NE}; pg8::gemm_phase<pg8::EpiF32, pg8::DenseSched, true>(F.lds, 1024, S, E); }
}
template <int STAGE> __device__ __forceinline__ void phase_moe_fast(const Ctx& F) {
    const int nrt = (int)__hip_atomic_load((unsigned*)(F.ws + WS_CTL) + CW_NRT, __ATOMIC_RELAXED, __HIP_MEMORY_SCOPE_AGENT);
    pg8::MoeSched<STAGE> S;
    S.tile_e = (const int*)(F.ws + WS_TILEE); S.tokp = (const int*)(F.ws + WS_TOKP); S.ypos = (const int*)(F.ws + WS_YPOS); S.wpad = (const float*)(F.ws + WS_WPAD); S.nrt = nrt; S.nU = (nrt + T / 256) * pg8::MoeSched<STAGE>::NPN; S.G = F.G; S.c = F.blk;
    if (STAGE == 1) { S.Abase = (const char*)(F.ws + (MOE1_FP8 ? WS_H2F8 : WS_A2)); S.Bbase = (const char*)(F.ws + WS_WGU); pg8::EpiHid E{(bf16*)(F.ws + WS_A3)};
        pg8::gemm_phase<pg8::EpiHid, pg8::MoeSched<STAGE>, true, pg8::MoeSched<STAGE>::F8>(F.lds, pg8::MoeSched<STAGE>::K, S, E); }
    else { S.Abase = (const char*)(F.ws + WS_A3); S.Bbase = (const char*)(F.ws + WS_WD); pg8::EpiY E{(unsigned char*)(F.ws + WS_Y)};
        int Kk = pg8::MoeSched<STAGE>::K; asm volatile("" : "+s"(Kk));
        pg8::gemm_phase<pg8::EpiY, pg8::MoeSched<STAGE>, false, pg8::MoeSched<STAGE>::F8>(F.lds, Kk, S, E); }
}

__device__ __forceinline__ unsigned cvtpk(float lo, float hi) { unsigned r; asm volatile("v_cvt_pk_bf16_f32 %0, %1, %2" : "=v"(r) : "v"(lo), "v"(hi)); return r; }
__device__ __forceinline__ void store_o_tile(const f32x16 (&o)[2], bf16* dst, LAS unsigned char* stg, int lane) {
    const int r32 = lane & 31, hi = lane >> 5;
    if (F8B) {
#pragma unroll
        for (int dt = 0; dt < 2; ++dt)
#pragma unroll
            for (int r = 0; r < 16; ++r) { const int t = __builtin_amdgcn_cvt_pk_fp8_f32(o[dt][r] * ATT8_SCALE, 0.f, 0, false); *(LAS unsigned char*)(stg + crow(r, hi) * 64 + 32 * dt + r32) = (unsigned char)t; }
        LDS_WAIT(); asm volatile("" ::: "memory");
#pragma unroll
        for (int i = 0; i < 2; ++i) { const int row = i * 16 + (lane >> 2), ch = lane & 3; *(u32x4*)((unsigned char*)dst + (size_t)row * 512 + ch * 16) = *(const LAS u32x4*)(stg + row * 64 + ch * 16); }
        LDS_WAIT(); asm volatile("" ::: "memory");
        return;
    }
#pragma unroll
    for (int dt = 0; dt < 2; ++dt)
#pragma unroll
        for (int r = 0; r < 16; ++r) *(LAS unsigned short*)(stg + crow(r, hi) * 128 + (32 * dt + r32) * 2) = (unsigned short)f2bf(o[dt][r]);
    LDS_WAIT(); asm volatile("" ::: "memory");
#pragma unroll
    for (int i = 0; i < 4; ++i) { const int row = i * 8 + (lane >> 3), ch = lane & 7; *(u32x4*)(dst + (size_t)row * 512 + ch * 8) = *(const LAS u32x4*)(stg + row * 128 + ch * 16); }
    LDS_WAIT(); asm volatile("" ::: "memory");
}
__device__ __forceinline__ void phase_swa(const Ctx& F) { const float* const p_sinks = F.in(7); const float* const p_relb = F.in(8);
    const bf16* proj = (const bf16*)(F.ws + WS_PROJ);
    bf16* ya = (bf16*)(F.ws + WS_A2);
    LAS unsigned char* Kl = F.lds;
    LAS unsigned char* Vl = F.lds + 24576;
    LAS float* biasL = (LAS float*)(F.lds + 49152);
    LAS unsigned char* stg = F.lds + 65536 + F.wave * 4096;
    const int r32 = F.lane & 31, hi = F.lane >> 5;
    __syncthreads();
    for (int i = F.tid; i < 8 * 384; i += NTHR) { const int hd = i / 384, ri = i % 384; biasL[i] = p_relb[(int)T5B[ri] * 8 + hd] * LOG2E; }
    constexpr int NU = NB * 32 * 2;
    const int g = F.wave >> 1, qh = F.wave & 1;
    const int skey = F.tid >> 3, sch = F.tid & 7;
    u32x4 kreg[3], vreg[3]; u32x4 qn[4];
#define SWA_DECODE(uu, hk_, c_, b_, nkc_, kstart_) const int hk_ = (uu) & 1, c_ = ((uu) >> 1) & 31, b_ = (uu) >> 6; const int nkc_ = (c_ < 2 ? c_ : 2) + 1, kstart_ = (c_ - nkc_ + 1) * 64
#define SWA_REQUEST(uu) do { SWA_DECODE(uu, hk_, c_, b_, nkc_, ks_); \
        _Pragma("unroll") for (int i = 0; i < 3; ++i) { const int key = skey + 64 * i; const int keyc = key < nkc_ * 64 ? key : 0; const bf16* s_ = proj + (size_t)(b_ * SEQ + ks_ + keyc) * INW + hk_ * 64 + sch * 8; \
            kreg[i] = *(const u32x4*)(s_ + C_KA); vreg[i] = *(const u32x4*)(s_ + C_VA); } \
        _Pragma("unroll") for (int d0 = 0; d0 < 4; ++d0) qn[d0] = *(const u32x4*)(proj + (size_t)(b_ * SEQ + c_ * 64 + qh * 32 + r32) * INW + C_QA + (hk_ * 4 + g) * 64 + d0 * 16 + hi * 8); } while (0)
    int u = F.blk;
    if (u < NU) SWA_REQUEST(u);
    for (; u < NU; u += F.G) {
        SWA_DECODE(u, hk, c, b, nkc, kstart); const int nk = nkc * 64, nkt = nkc * 2;
        __syncthreads();
#pragma unroll
        for (int i = 0; i < 3; ++i) { const int key = skey + 64 * i;
            if (key < nk) { *(LAS u32x4*)(Kl + sch * 3072 + key * 16) = kreg[i]; *(LAS u32x4*)(Vl + (sch >> 2) * 12288 + key * 64 + (sch & 3) * 16) = vreg[i]; } }
        bf16x8 qf[4];
#pragma unroll
        for (int d0 = 0; d0 < 4; ++d0) { const float sc = 0.125f * LOG2E; u32x4 qs; const u32x4 qv = qn[d0];
            qs.x = cvtpk(bflo(qv.x) * sc, bfhi(qv.x) * sc); qs.y = cvtpk(bflo(qv.y) * sc, bfhi(qv.y) * sc); qs.z = cvtpk(bflo(qv.z) * sc, bfhi(qv.z) * sc); qs.w = cvtpk(bflo(qv.w) * sc, bfhi(qv.w) * sc);
            qf[d0] = __builtin_bit_cast(bf16x8, qs); }
        __syncthreads();
        { const int un = (u + F.G < NU) ? u + F.G : u; SWA_REQUEST(un); }
        const int head = hk * 4 + g, qpos = c * 64 + qh * 32 + r32;
        f32x16 sc[6];
#pragma unroll
        for (int kt = 0; kt < 6; ++kt) {
            sc[kt] = (f32x16){0.f, 0.f, 0.f, 0.f, 0.f, 0.f, 0.f, 0.f, 0.f, 0.f, 0.f, 0.f, 0.f, 0.f, 0.f, 0.f};
            if (kt < nkt) {
#pragma unroll
                for (int d0 = 0; d0 < 4; ++d0) { const bf16x8 kf = *(const LAS bf16x8*)(Kl + (2 * d0 + hi) * 3072 + (32 * kt + r32) * 16);
                    sc[kt] = __builtin_amdgcn_mfma_f32_32x32x16_bf16(kf, qf[d0], sc[kt], 0, 0, 0); }
            }
        }
        const float sink2 = p_sinks[head] * LOG2E;
        float m = sink2;
        const LAS float* bl = biasL + head * 384 + 255 + (kstart - qpos);
#pragma unroll
        for (int kt = 0; kt < 6; ++kt) if (kt < nkt) {
#pragma unroll
            for (int r = 0; r < 16; ++r) { const float l2 = sc[kt][r] + bl[32 * kt + crow(r, hi)]; sc[kt][r] = l2; m = fmaxf(m, l2); }
        }
        m = fmaxf(m, __shfl_xor(m, 32));
        float sum = 0.f;
#pragma unroll
        for (int kt = 0; kt < 6; ++kt) if (kt < nkt) {
#pragma unroll
            for (int r = 0; r < 16; ++r) { const float p = ex2(sc[kt][r] - m); sc[kt][r] = p; sum += p; }
        }
        sum += __shfl_xor(sum, 32);
        const float inv = 1.0f / (sum + ex2(sink2 - m));
        f32x16 o[2];
        o[0] = (f32x16){0.f, 0.f, 0.f, 0.f, 0.f, 0.f, 0.f, 0.f, 0.f, 0.f, 0.f, 0.f, 0.f, 0.f, 0.f, 0.f}; o[1] = o[0];
        const int vlane = ((F.lane >> 4) & 1) * 32 + (F.lane & 3) * 8 + (4 * hi + ((F.lane & 15) >> 2)) * 64;
#pragma unroll
        for (int kt = 0; kt < 6; ++kt) if (kt < nkt) {
#pragma unroll
            for (int ks = 0; ks < 2; ++ks) {
                u32x4 pw; pw.x = cvtpk(sc[kt][8 * ks] * inv, sc[kt][8 * ks + 1] * inv); pw.y = cvtpk(sc[kt][8 * ks + 2] * inv, sc[kt][8 * ks + 3] * inv);
                pw.z = cvtpk(sc[kt][8 * ks + 4] * inv, sc[kt][8 * ks + 5] * inv); pw.w = cvtpk(sc[kt][8 * ks + 6] * inv, sc[kt][8 * ks + 7] * inv);
                const bf16x8 pa = __builtin_bit_cast(bf16x8, pw);
#pragma unroll
                for (int dt = 0; dt < 2; ++dt) {
                    const LAS unsigned char* vp = Vl + dt * 12288 + (32 * kt + 16 * ks) * 64 + vlane;
                    const s16x4 lo = vtr(vp), hh = vtr(vp + 512);
                    const bf16x8 vf = (bf16x8){lo[0], lo[1], lo[2], lo[3], hh[0], hh[1], hh[2], hh[3]};
                    o[dt] = __builtin_amdgcn_mfma_f32_32x32x16_bf16(pa, vf, o[dt], 0, 0, 0);
                }
            }
        }
        if (F8B) store_o_tile(o, (bf16*)((unsigned char*)ya + (size_t)(b * SEQ + c * 64 + qh * 32) * 512 + head * 64), stg, F.lane);
        else store_o_tile(o, ya + (size_t)(b * SEQ + c * 64 + qh * 32) * 512 + head * 64, stg, F.lane);
    }
#undef SWA_DECODE
#undef SWA_REQUEST
}

__device__ __forceinline__ void phase_sb(const Ctx& F) {
    const bf16* proj = (const bf16*)(F.ws + WS_PROJ);
    bf16* yb = (bf16*)(F.ws + WS_A2) + (size_t)T * 512;
    volatile LAS int* flags = (volatile LAS int*)(F.lds + 131072);
    const int r32 = F.lane & 31, hi = F.lane >> 5;
    const int vlane = ((F.lane >> 4) & 1) * 32 + (F.lane & 3) * 8 + (4 * hi + ((F.lane & 15) >> 2)) * 64;
    const int skey = F.tid >> 3, sch = F.tid & 7;
    const unsigned kw = sch * 1024 + skey * 16, vw = 8192 + (sch >> 2) * 4096 + skey * 64 + (sch & 3) * 16;
    const int wh = F.wave >> 1, wq = F.wave & 1;
    for (int u = F.blk; u < NB * 2 * 32; u += F.G) {
        const int qb = (u + (u >> 5)) & 31, hg = (u >> 5) & 1, b = u >> 6;
        const int q0 = qb * 64, qw = q0 + wq * 32, qpos = qw + r32, head = hg * 4 + wh;
        const bf16* kvsrc = proj + (size_t)(b * SEQ + skey) * INW + hg * 256 + sch * 8;
        const int kt0 = qb;
        __syncthreads();
        u32x4 kreg[4], vreg[4];
#pragma unroll
        for (int i = 0; i < 4; ++i) { kreg[i] = *(const u32x4*)(kvsrc + (size_t)kt0 * 64 * INW + C_KB + i * 64); vreg[i] = *(const u32x4*)(kvsrc + (size_t)kt0 * 64 * INW + C_VB + i * 64); }
        bf16x8 qf[4];
#pragma unroll
        for (int d0 = 0; d0 < 4; ++d0) {
            const u32x4 qv = *(const u32x4*)(proj + (size_t)(b * SEQ + qpos) * INW + C_QB + head * 64 + d0 * 16 + hi * 8); u32x4 qs; const float sc = 0.125f * LOG2E;
            qs.x = cvtpk(bflo(qv.x) * sc, bfhi(qv.x) * sc); qs.y = cvtpk(bflo(qv.y) * sc, bfhi(qv.y) * sc); qs.z = cvtpk(bflo(qv.z) * sc, bfhi(qv.z) * sc); qs.w = cvtpk(bflo(qv.w) * sc, bfhi(qv.w) * sc);
            qf[d0] = __builtin_bit_cast(bf16x8, qs); }
#pragma unroll
        for (int i = 0; i < 4; ++i) { *(LAS u32x4*)(F.lds + i * 16384 + kw) = kreg[i]; *(LAS u32x4*)(F.lds + i * 16384 + vw) = vreg[i]; }
        if (kt0 >= 1) {
#pragma unroll
            for (int i = 0; i < 4; ++i) { kreg[i] = *(const u32x4*)(kvsrc + (size_t)(kt0 - 1) * 64 * INW + C_KB + i * 64); vreg[i] = *(const u32x4*)(kvsrc + (size_t)(kt0 - 1) * 64 * INW + C_VB + i * 64); } }
        f32x16 o[2];
        o[0] = (f32x16){0.f, 0.f, 0.f, 0.f, 0.f, 0.f, 0.f, 0.f, 0.f, 0.f, 0.f, 0.f, 0.f, 0.f, 0.f, 0.f}; o[1] = o[0];
        float R = 1.f; bool mydone = false;
        __syncthreads();
        for (int kt = kt0, it = 0; kt >= 0; --kt, ++it) {
            const int kb = kt * 64;
            LAS unsigned char* Kl = F.lds + (it & 1) * 65536 + wh * 16384; LAS unsigned char* Vl = Kl + 8192;
            if (!mydone) {
                f32x16 p0 = (f32x16){0.f, 0.f, 0.f, 0.f, 0.f, 0.f, 0.f, 0.f, 0.f, 0.f, 0.f, 0.f, 0.f, 0.f, 0.f, 0.f}, p1 = p0;
#pragma unroll
                for (int d0 = 0; d0 < 4; ++d0) {
                    const bf16x8 k0f = *(const LAS bf16x8*)(Kl + (2 * d0 + hi) * 1024 + r32 * 16), k1f = *(const LAS bf16x8*)(Kl + (2 * d0 + hi) * 1024 + (32 + r32) * 16);
                    p0 = __builtin_amdgcn_mfma_f32_32x32x16_bf16(k0f, qf[d0], p0, 0, 0, 0);
                    p1 = __builtin_amdgcn_mfma_f32_32x32x16_bf16(k1f, qf[d0], p1, 0, 0, 0);
                }
                float kp[32], lb[32];
                const bool diag = (kt == kt0);
#pragma unroll
                for (int e = 0; e < 32; ++e) {
                    const float z2 = (e < 16 ? p0[e] : p1[e - 16]);
                    const float uu = ex2(-fabsf(z2)), rr_ = __builtin_amdgcn_rcpf(1.0f + uu), ur = uu * rr_;
                    const bool pos = z2 >= 0.f;
                    lb[e] = pos ? rr_ : ur; kp[e] = pos ? ur : rr_;
                }
                if (diag) {
#pragma unroll
                    for (int e = 0; e < 32; ++e) { const bool valid = (kb + 8 * (e >> 2) + 4 * hi + (e & 3)) < qpos; kp[e] = valid ? kp[e] : 1.f; lb[e] = valid ? lb[e] : 0.f; }
                }
                float A = R;
#pragma unroll
                for (int i = 7; i >= 0; --i) {
                    const float gs = (kp[4 * i] * kp[4 * i + 1]) * (kp[4 * i + 2] * kp[4 * i + 3]);
                    const auto rr = __builtin_amdgcn_permlane32_swap(__float_as_uint(gs), __float_as_uint(gs), false, false);
                    const float g0 = __uint_as_float(rr[0]), g1 = __uint_as_float(rr[1]);
                    const float c3 = A * (hi == 0 ? g1 : 1.f), c2 = c3 * kp[4 * i + 3], c1 = c2 * kp[4 * i + 2], c0 = c1 * kp[4 * i + 1];
                    lb[4 * i + 3] *= c3; lb[4 * i + 2] *= c2; lb[4 * i + 1] *= c1; lb[4 * i] *= c0;
                    A *= g0 * g1;
                }
                R = A;
#pragma unroll
                for (int k4 = 0; k4 < 4; ++k4) {
                    u32x4 pw; pw.x = cvtpk(lb[8 * k4], lb[8 * k4 + 1]); pw.y = cvtpk(lb[8 * k4 + 2], lb[8 * k4 + 3]); pw.z = cvtpk(lb[8 * k4 + 4], lb[8 * k4 + 5]); pw.w = cvtpk(lb[8 * k4 + 6], lb[8 * k4 + 7]);
                    const bf16x8 pa = __builtin_bit_cast(bf16x8, pw);
#pragma unroll
                    for (int dt = 0; dt < 2; ++dt) {
                        const LAS unsigned char* vp = Vl + dt * 4096 + (16 * k4) * 64 + vlane;
                        const s16x4 lo = vtr(vp), hh = vtr(vp + 512);
                        const bf16x8 vf = (bf16x8){lo[0], lo[1], lo[2], lo[3], hh[0], hh[1], hh[2], hh[3]};
                        o[dt] = __builtin_amdgcn_mfma_f32_32x32x16_bf16(pa, vf, o[dt], 0, 0, 0);
                    }
                }
                mydone = __all(R < 3.5e-15f);
            }
            if (kt >= 1) { LAS unsigned char* nb = F.lds + ((it + 1) & 1) * 65536;
#pragma unroll
                for (int i = 0; i < 4; ++i) { *(LAS u32x4*)(nb + i * 16384 + kw) = kreg[i]; *(LAS u32x4*)(nb + i * 16384 + vw) = vreg[i]; } }
            if (kt >= 2) {
#pragma unroll
                for (int i = 0; i < 4; ++i) { kreg[i] = *(const u32x4*)(kvsrc + (size_t)(kt - 2) * 64 * INW + C_KB + i * 64); vreg[i] = *(const u32x4*)(kvsrc + (size_t)(kt - 2) * 64 * INW + C_VB + i * 64); } }
            if (F.lane == 0) flags[(it & 1) * 8 + F.wave] = mydone ? 1 : 0;
            __syncthreads();
            int alld = 1;
#pragma unroll
            for (int w = 0; w < 8; ++w) alld &= flags[(it & 1) * 8 + w];
            if (alld) break;
        }
        if (F8B) store_o_tile(o, (bf16*)((unsigned char*)(F.ws + WS_A2) + (size_t)T * 512 + (size_t)(b * SEQ + qw) * 512 + head * 64), F.lds + F.wave * 4096, F.lane);
        else store_o_tile(o, yb + (size_t)(b * SEQ + qw) * 512 + head * 64, F.lds + F.wave * 4096, F.lane);
    }
}

__device__ __forceinline__ void phase_mid(const Ctx& F) { const float* const p_x = F.in(0); const float* const p_gpost = F.in(5); const float* const p_gpre = F.in(12);
    const int gw = F.blk * NWAVES + F.wave, NGW = F.G * NWAVES;
    const float* mod = (const float*)(F.ws + WS_MOD);
    const bf16* o = (const bf16*)(F.ws + (F8O ? WS_A3 : WS_A1));
    bf16* h2 = (bf16*)(F.ws + WS_A2); bf16* xmid = (bf16*)(F.ws + WS_XMID);
    for (int ch = gw; ch < T / 16; ch += NGW) {
        const int row0 = ch * 16, b = row0 / SEQ;
        f32x4 gp[4], g2[4], s2[4];
#pragma unroll
        for (int j = 0; j < 4; ++j) { const int col = 4 * F.lane + 256 * j;
            gp[j] = *(const f32x4*)(p_gpost + col) * *(const f32x4*)(mod + b * 6144 + 2 * 1024 + col);
            g2[j] = *(const f32x4*)(p_gpre + col) * (*(const f32x4*)(mod + b * 6144 + 4 * 1024 + col) + 1.0f);
            s2[j] = *(const f32x4*)(mod + b * 6144 + 3 * 1024 + col); }
        for (int rr = 0; rr < 16; ++rr) {
            const size_t row = (size_t)(row0 + rr);
            f32x4 v[4], xv[4]; float s = 0.f;
#pragma unroll
            for (int j = 0; j < 4; ++j) { const u32x2 w = *(const u32x2*)(o + row * DM + 4 * F.lane + 256 * j);
                v[j] = (f32x4){bflo(w.x), bfhi(w.x), bflo(w.y), bfhi(w.y)}; xv[j] = *(const f32x4*)(p_x + row * DM + 4 * F.lane + 256 * j);
                s += (v[j].x * v[j].x + v[j].y * v[j].y) + (v[j].z * v[j].z + v[j].w * v[j].w); }
            const float r1 = 1.0f / sqrtf(wave_sum(s) * (1.f / DM) + RMS_EPS);
            float q = 0.f;
#pragma unroll
            for (int j = 0; j < 4; ++j) { xv[j] = xv[j] + v[j] * r1 * gp[j]; { u32x2 w; w.x = pk2(xv[j].x, xv[j].y); w.y = pk2(xv[j].z, xv[j].w); *(u32x2*)(xmid + row * DM + 4 * F.lane + 256 * j) = w; }
                q += (xv[j].x * xv[j].x + xv[j].y * xv[j].y) + (xv[j].z * xv[j].z + xv[j].w * xv[j].w); }
            const float r2 = 1.0f / sqrtf(wave_sum(q) * (1.f / DM) + RMS_EPS);
#pragma unroll
            for (int j = 0; j < 4; ++j) { const f32x4 hv = xv[j] * r2 * g2[j] + s2[j]; u32x2 w; w.x = pk2(hv.x, hv.y); w.y = pk2(hv.z, hv.w); *(u32x2*)(h2 + row * DM + 4 * F.lane + 256 * j) = w;
                if (MOE1_FP8) { int t8 = 0; t8 = __builtin_amdgcn_cvt_pk_fp8_f32(hv.x, hv.y, t8, false); t8 = __builtin_amdgcn_cvt_pk_fp8_f32(hv.z, hv.w, t8, true); *(unsigned*)(F.ws + WS_H2F8 + row * DM + 4 * F.lane + 256 * j) = (unsigned)t8; } }
        }
    }
}

__device__ __forceinline__ unsigned fkey(float v) { const unsigned k = __float_as_uint(v); return (k & 0x80000000u) ? ~k : (k | 0x80000000u); }
__device__ __forceinline__ int mbcnt64(unsigned long long b) { return (int)__builtin_amdgcn_mbcnt_hi((unsigned)(b >> 32), __builtin_amdgcn_mbcnt_lo((unsigned)b, 0u)); }
__device__ __forceinline__ void phase_route(const Ctx& F) { const float* const p_rb = F.in(15);
    const float* logits = (const float*)(F.ws + WS_A1);
    int* idxg = (int*)(F.ws + WS_IDX); float* wtg = (float*)(F.ws + WS_WT); int* rankg = (int*)(F.ws + WS_RANK);
    unsigned* bb = (unsigned*)(F.ws + WS_BB);
    unsigned* gcnt = (unsigned*)(F.ws + WS_CTL) + CW_GCNT;
    LAS int* hist = (LAS int*)(F.lds);
    __syncthreads();
    if (F.tid < NE) hist[F.tid] = 0;
    __syncthreads();
    const int tpb = (T + F.G - 1) / F.G, t0 = F.blk * tpb, t1 = (t0 + tpb < T) ? t0 + tpb : T;
    const f32x4 rb = *(const f32x4*)(p_rb + 4 * F.lane);
    for (int t = t0 + F.wave; t < t1; t += NWAVES) {
        const f32x4 lg = *(const f32x4*)(logits + (size_t)t * NE + 4 * F.lane);
        const float s0 = sigmoidf_(lg.x), s1 = sigmoidf_(lg.y), s2 = sigmoidf_(lg.z), s3 = sigmoidf_(lg.w);
        const float c0 = s0 + rb.x, c1 = s1 + rb.y, c2 = s2 + rb.z, c3 = s3 + rb.w;
        float m1 = fmaxf(c0, c1), m2 = fminf(c0, c1);
        m2 = fmaxf(m2, fminf(m1, c2)); m1 = fmaxf(m1, c2);
        m2 = fmaxf(m2, fminf(m1, c3)); m1 = fmaxf(m1, c3);
#pragma unroll
        for (int off = 1; off < 8; off <<= 1) { const float o1 = __shfl_xor(m1, off), o2 = __shfl_xor(m2, off);
            const float n2 = fmaxf(fminf(m1, o1), fmaxf(m2, o2)); m1 = fmaxf(m1, o1); m2 = n2; }
        const float gs = m1 + m2; const int mygrp = F.lane >> 3; int rk = 0;
#pragma unroll
        for (int g2 = 0; g2 < 8; ++g2) { const float og = __shfl(gs, 8 * g2); rk += ((og > gs) || (og == gs && g2 < mygrp)) ? 1 : 0; }
        const bool sel = rk < 4;
        const unsigned k0 = sel ? fkey(c0) : 0u, k1 = sel ? fkey(c1) : 0u, k2 = sel ? fkey(c2) : 0u, k3 = sel ? fkey(c3) : 0u;
        unsigned Tk = 0u;
#pragma unroll
        for (int bit = 31; bit >= 0; --bit) {
            const unsigned cand = Tk | (1u << bit);
            const int cnt = __builtin_popcountll(__ballot(k0 >= cand)) + __builtin_popcountll(__ballot(k1 >= cand)) + __builtin_popcountll(__ballot(k2 >= cand)) + __builtin_popcountll(__ballot(k3 >= cand));
            Tk = (cnt >= TOPK) ? cand : Tk;
        }
        const bool g0 = k0 > Tk, g1 = k1 > Tk, g2 = k2 > Tk, g3 = k3 > Tk, e0 = k0 == Tk, e1 = k1 == Tk, e2 = k2 == Tk, e3 = k3 == Tk;
        const int need = TOPK - (__builtin_popcountll(__ballot(g0)) + __builtin_popcountll(__ballot(g1)) + __builtin_popcountll(__ballot(g2)) + __builtin_popcountll(__ballot(g3)));
        int eqb = mbcnt64(__ballot(e0)) + mbcnt64(__ballot(e1)) + mbcnt64(__ballot(e2)) + mbcnt64(__ballot(e3));
        const bool x0 = g0 || (e0 && eqb < need); eqb += e0 ? 1 : 0;
        const bool x1 = g1 || (e1 && eqb < need); eqb += e1 ? 1 : 0;
        const bool x2 = g2 || (e2 && eqb < need); eqb += e2 ? 1 : 0;
        const bool x3 = g3 || (e3 && eqb < need);
        int pos = mbcnt64(__ballot(x0)) + mbcnt64(__ballot(x1)) + mbcnt64(__ballot(x2)) + mbcnt64(__ballot(x3));
        const float ssum = wave_sum((x0 ? s0 : 0.f) + (x1 ? s1 : 0.f) + (x2 ? s2 : 0.f) + (x3 ? s3 : 0.f));
        const float wsc = 2.5f / ssum;
#define ROUTE_EMIT(x, j, s) if (x) { const int e_ = 4 * F.lane + (j); const int rkl = __hip_atomic_fetch_add(hist + e_, 1, __ATOMIC_RELAXED, __HIP_MEMORY_SCOPE_WORKGROUP); \
            idxg[(size_t)t * TOPK + pos] = e_; wtg[(size_t)t * TOPK + pos] = (s) * wsc; rankg[(size_t)t * TOPK + pos] = rkl; ++pos; }
        ROUTE_EMIT(x0, 0, s0) ROUTE_EMIT(x1, 1, s1) ROUTE_EMIT(x2, 2, s2) ROUTE_EMIT(x3, 3, s3)
#undef ROUTE_EMIT
    }
    __syncthreads();
    if (F.tid < NE) bb[F.blk * NE + F.tid] = __hip_atomic_fetch_add(gcnt + F.tid, (unsigned)hist[F.tid], __ATOMIC_RELAXED, __HIP_MEMORY_SCOPE_AGENT);
}

__device__ __forceinline__ void phase_scatter(const Ctx& F) {
    const int* idxg = (const int*)(F.ws + WS_IDX); const float* wtg = (const float*)(F.ws + WS_WT); const int* rankg = (const int*)(F.ws + WS_RANK);
    int* posg = (int*)(F.ws + WS_POS); int* tokp = (int*)(F.ws + WS_TOKP); int* ypos = (int*)(F.ws + WS_YPOS); float* wpad = (float*)(F.ws + WS_WPAD);
    const unsigned* bb = (const unsigned*)(F.ws + WS_BB);
    const unsigned* gcnt = (const unsigned*)(F.ws + WS_CTL) + CW_GCNT;
    int* tile_e = (int*)(F.ws + WS_TILEE);
    LAS int* cnt = (LAS int*)(F.lds); LAS int* pst = cnt + 256; LAS int* cst = cnt + 512; LAS int* base = cnt + 768;
    __syncthreads();
    if (F.tid < NE) cnt[F.tid] = (int)__hip_atomic_load(gcnt + F.tid, __ATOMIC_RELAXED, __HIP_MEMORY_SCOPE_AGENT);
    __syncthreads();
    if (F.tid < NE) { int ps = 0, cs = 0; for (int e = 0; e < F.tid; ++e) { ps += (cnt[e] + 255) & ~255; cs += cnt[e]; } pst[F.tid] = ps; cst[F.tid] = cs; base[F.tid] = (int)bb[F.blk * NE + F.tid]; }
    __syncthreads();
    const int tpb = (T + F.G - 1) / F.G, t0 = F.blk * tpb, t1 = (t0 + tpb < T) ? t0 + tpb : T;
    for (int i = t0 * TOPK + F.tid; i < t1 * TOPK; i += NTHR) {
        const int e = idxg[i], r = rankg[i] + base[e], p = pst[e] + r, cp = cst[e] + r;
        tokp[p] = i >> 3; ypos[p] = cp; wpad[p] = wtg[i]; posg[i] = cp;
    }
    for (int e = F.blk; e < NE; e += F.G) {
        const int ps = pst[e], n = cnt[e], pe = ps + ((n + 255) & ~255);
        for (int p = ps + n + F.tid; p < pe; p += NTHR) { tokp[p] = -1; ypos[p] = -1; wpad[p] = 0.f; }
        for (int tl = ps / 256 + F.tid; tl < pe / 256; tl += NTHR) tile_e[tl] = e;
        if (e == NE - 1 && F.tid == 0) ((unsigned*)(F.ws + WS_CTL))[CW_NRT] = (unsigned)(pe / 256);
    }
    for (int t = F.blk * NTHR + F.tid; t < T; t += F.G * NTHR) { tokp[PADCAP + t] = t; ypos[PADCAP + t] = NASSIGN + t; wpad[PADCAP + t] = 1.0f; }
    for (int s = F.blk * NTHR + F.tid; s < T / 256; s += F.G * NTHR) tile_e[SH_TILE0 + s] = NE;
}

template <int STAGE> __device__ __forceinline__ void phase_moe(const Ctx& F) {
    const int* tokp = (const int*)(F.ws + WS_TOKP); const int* ypos = (const int*)(F.ws + WS_YPOS); const float* wpad = (const float*)(F.ws + WS_WPAD);
    const int* tile_e = (const int*)(F.ws + WS_TILEE);
    const int nrt = (int)__hip_atomic_load((unsigned*)(F.ws + WS_CTL) + CW_NRT, __ATOMIC_RELAXED, __HIP_MEMORY_SCOPE_AGENT);
    const int ntl = nrt + T / 256;
    const bf16* h2 = (const bf16*)(F.ws + WS_A2);
    bf16* hid = (bf16*)(F.ws + WS_A3);
    unsigned char* Y = (unsigned char*)(F.ws + WS_Y);
    const int r32 = F.lane & 31, hi = F.lane >> 5, wm = F.wave >> 2, wn = F.wave & 3;
    const int prow = F.tid >> 3, pch = F.tid & 7;
    constexpr int NPN = (STAGE == 1) ? 2 : 4, K = (STAGE == 1) ? 1024 : 256;
    const int nU = ntl * 2 * NPN;
    for (int u = F.blk; u < nU; u += F.G) {
        const int pn = u % NPN, hm = (u / NPN) & 1, tq = u / (2 * NPN);
        const int tile = tq < nrt ? tq : SH_TILE0 + (tq - nrt);
        const int e = tile_e[tile], p0 = tile * 256 + hm * 128;
        if (tokp[p0] < 0) continue;
        const char *pa0, *pa1;
        if (STAGE == 1) { int ta = tokp[p0 + prow], tb = tokp[p0 + prow + 64]; ta = ta < 0 ? 0 : ta; tb = tb < 0 ? 0 : tb;
            pa0 = (const char*)(h2 + (size_t)ta * DM) + pch * 16; pa1 = (const char*)(h2 + (size_t)tb * DM) + pch * 16; }
        else { pa0 = (const char*)(hid + (size_t)(p0 + prow) * EDIM) + pch * 16; pa1 = pa0 + 64 * EDIM * 2; }
        const bf16* Bt = (STAGE == 1) ? (const bf16*)(F.ws + WS_WGU) + (size_t)e * 512 * 1024 : (const bf16*)(F.ws + WS_WD) + (size_t)e * 1024 * 256;
        const char* pb0 = (const char*)(Bt + (size_t)(pn * 256 + prow) * K) + pch * 16;
        const size_t bs = (size_t)64 * K * 2;
        f32x16 acc[2][2];
        sg_mainloop(F.lds, pa0, pa1, pb0, pb0 + bs, pb0 + 2 * bs, pb0 + 3 * bs, K, acc);
#pragma unroll
        for (int mt = 0; mt < 2; ++mt) {
            const int p = p0 + wm * 64 + mt * 32 + r32;
            if (STAGE == 1) {
#pragma unroll
                for (int rg = 0; rg < 4; ++rg) {
                    float hv[4];
#pragma unroll
                    for (int q = 0; q < 4; ++q) { const float gt = acc[mt][0][4 * rg + q], up = acc[mt][1][4 * rg + q]; hv[q] = gt * sigmoidf_(gt) * up; }
                    u32x2 w; w.x = pk2(hv[0], hv[1]); w.y = pk2(hv[2], hv[3]);
                    *(u32x2*)(hid + (size_t)p * EDIM + pn * 128 + wn * 32 + 8 * rg + 4 * hi) = w;
                }
            } else {
                const int tk = tokp[p];
                if (tk >= 0) {
                    const float wv = wpad[p] * Y8_SCALE; unsigned char* yr = Y + (size_t)ypos[p] * DM + pn * 256;
#pragma unroll
                    for (int j = 0; j < 2; ++j)
#pragma unroll
                        for (int rg = 0; rg < 4; ++rg) { int t = 0; t = __builtin_amdgcn_cvt_pk_fp8_f32(acc[mt][j][4 * rg] * wv, acc[mt][j][4 * rg + 1] * wv, t, false);
                            t = __builtin_amdgcn_cvt_pk_fp8_f32(acc[mt][j][4 * rg + 2] * wv, acc[mt][j][4 * rg + 3] * wv, t, true);
                            *(unsigned*)(yr + j * 128 + wn * 32 + 8 * rg + 4 * hi) = (unsigned)t; }
                }
            }
        }
    }
}

__device__ __forceinline__ void phase_combine(const Ctx& F) { const float* const p_gff = F.in(13);
    const int gw = F.blk * NWAVES + F.wave, NGW = F.G * NWAVES;
    const float* mod = (const float*)(F.ws + WS_MOD);
    const int* posg = (const int*)(F.ws + WS_POS);
    const unsigned char* Y = (const unsigned char*)(F.ws + WS_Y); const bf16* xmid = (const bf16*)(F.ws + WS_XMID);
    typedef float f32x2 __attribute__((ext_vector_type(2)));
    for (int ch = gw; ch < T / 16; ch += NGW) {
        const int row0 = ch * 16, b = row0 / SEQ;
        f32x4 gg[4];
#pragma unroll
        for (int j = 0; j < 4; ++j) { const int col = 16 * F.lane + 4 * j; gg[j] = *(const f32x4*)(p_gff + col) * *(const f32x4*)(mod + b * 6144 + 5 * 1024 + col); }
        for (int rr = 0; rr < 16; ++rr) {
            const int t = row0 + rr;
            f32x4 y[4];
#pragma unroll
            for (int j = 0; j < 4; ++j) y[j] = (f32x4){0.f, 0.f, 0.f, 0.f};
            u32x4 w[TOPK + 1];
#pragma unroll
            for (int k = 0; k < TOPK + 1; ++k) { const size_t yr = (k < TOPK) ? (size_t)posg[(size_t)t * TOPK + k] : (size_t)(NASSIGN + t); w[k] = *(const u32x4*)(Y + yr * DM + 16 * F.lane); }
#pragma unroll
            for (int k = 0; k < TOPK + 1; ++k)
#pragma unroll
                for (int j = 0; j < 4; ++j) { const f32x2 lo = __builtin_amdgcn_cvt_pk_f32_fp8((int)w[k][j], false), hi = __builtin_amdgcn_cvt_pk_f32_fp8((int)w[k][j], true);
                    y[j] += (f32x4){lo.x, lo.y, hi.x, hi.y}; }
            float s = 0.f;
#pragma unroll
            for (int j = 0; j < 4; ++j) { y[j] = y[j] * (1.0f / Y8_SCALE); s += (y[j].x * y[j].x + y[j].y * y[j].y) + (y[j].z * y[j].z + y[j].w * y[j].w); }
            const float r = 1.0f / sqrtf(wave_sum(s) * (1.f / DM) + RMS_EPS);
            const u32x4 xw0 = *(const u32x4*)(xmid + (size_t)t * DM + 16 * F.lane), xw1 = *(const u32x4*)(xmid + (size_t)t * DM + 16 * F.lane + 8);
            const f32x4 xm[4] = {(f32x4){bflo(xw0.x), bfhi(xw0.x), bflo(xw0.y), bfhi(xw0.y)}, (f32x4){bflo(xw0.z), bfhi(xw0.z), bflo(xw0.w), bfhi(xw0.w)},
                                 (f32x4){bflo(xw1.x), bfhi(xw1.x), bflo(xw1.y), bfhi(xw1.y)}, (f32x4){bflo(xw1.z), bfhi(xw1.z), bflo(xw1.w), bfhi(xw1.w)}};
#pragma unroll
            for (int j = 0; j < 4; ++j) *(f32x4*)(F.out + (size_t)t * DM + 16 * F.lane + 4 * j) = xm[j] + y[j] * r * gg[j];
        }
    }
}

constexpr int NPHASE = 14;
struct Args { const float* in[22]; float* out; unsigned char* ws; int ph_lo, ph_hi; };
__global__ void __launch_bounds__(NTHR, 2) fwd(Args args) {
    extern __shared__ __attribute__((aligned(16))) unsigned char lds[];
    Ctx F;
    F.lds = (LAS unsigned char*)lds;
    F.tid = threadIdx.x; F.lane = F.tid & 63; F.wave = __builtin_amdgcn_readfirstlane(F.tid >> 6); F.G = gridDim.x; F.blk = blockIdx.x;
    F.out = args.out; F.ws = args.ws;
    volatile LAS unsigned* misc = (volatile LAS unsigned*)(F.lds + LDS_BYTES - 64);
    if (F.tid < 16) misc[F.tid] = 0u;
    __syncthreads();
    const int lo = args.ph_lo, hi = args.ph_hi;
    XcdBarrier bar; bar.bar = (unsigned*)(F.ws + WS_CTL) + CW_BAR; bar.x = 0; bar.st = nullptr;
    if (hi - lo > 1) bar = xcd_barrier_post((unsigned*)(F.ws + WS_CTL) + CW_BAR, misc);
#define IN(k) (lo <= (k) && (k) < hi)
#define SEAM(k) do { if (IN(k) && IN((k) + 1)) xcd_barrier(bar); } while (0)
    if (IN(0)) { phase_prologue(F); } SEAM(0);
    if (IN(1)) { phase_h(F); } SEAM(1);
    if (IN(2)) { if (FAST_DENSE) phase_dense_fast<0>(F); else phase_dense<0>(F); } SEAM(2);
    if (IN(3)) {
        if (NEW_CVT && !CVT_IN_P0 && !(F.blk & 1)) { cvt_experts<true>(F, F.lds + F.wave * 8448, CVT_G1, N_GU_ITEMS); __syncthreads(); }
        phase_swa(F); phase_sb(F);
        if (NEW_CVT && !CVT_IN_P0 && (F.blk & 1)) { __syncthreads(); cvt_experts<true>(F, F.lds + F.wave * 8448, CVT_G1, N_GU_ITEMS); }
    } SEAM(3);
    if (IN(4)) {
        if (NEW_CVT && !CVT_IN_P0 && !(F.blk & 1)) { cvt_experts<false>(F, F.lds + F.wave * 8448, 0, CVT_D1); __syncthreads(); }
        if (FAST_DENSE) phase_dense_fast<1>(F); else phase_dense<1>(F);
        if (NEW_CVT && !CVT_IN_P0 && (F.blk & 1)) { __syncthreads(); cvt_experts<false>(F, F.lds + F.wave * 8448, 0, CVT_D1); __syncthreads(); }
    }
    if (IN(5)) { if (FAST_DENSE) phase_dense_fast<2>(F); else phase_dense<2>(F); } SEAM(5);
    if (IN(6)) {
        if (NEW_CVT && !CVT_IN_P0 && !(F.blk & 1)) { cvt_experts<false>(F, F.lds + F.wave * 8448, CVT_D1, N_D_ITEMS); __syncthreads(); }
        if (FAST_DENSE) phase_dense_fast<3>(F); else phase_dense<3>(F);
        if (NEW_CVT && !CVT_IN_P0 && (F.blk & 1)) { __syncthreads(); cvt_experts<false>(F, F.lds + F.wave * 8448, CVT_D1, N_D_ITEMS); }
    } SEAM(6);
    if (IN(7)) { phase_mid(F); } SEAM(7);
    if (IN(8)) { if (FAST_DENSE) phase_dense_fast<4>(F); else phase_dense<4>(F); } SEAM(8);
    if (IN(9)) { phase_route(F); } SEAM(9);
    if (IN(10)) { phase_scatter(F); } SEAM(10);
    if (IN(11)) { if (FAST_MOE) phase_moe_fast<1>(F); else phase_moe<1>(F); } SEAM(11);
    if (IN(12)) { if (FAST_MOE) phase_moe_fast<2>(F); else phase_moe<2>(F); } SEAM(12);
    if (IN(13)) { phase_combine(F); }
#undef IN
#undef SEAM
}

extern "C" void kernel_launch(void* const* d_in, const int* in_sizes, int n_in, void* d_out, int out_size, void* d_ws, size_t ws_size, hipStream_t stream) {
    static int grid = 0;
    if (grid == 0) {
        if (n_in != 22 || in_sizes[0] != T * DM || out_size != T * DM || ws_size < WS_END) { fprintf(stderr, "kernel_launch: unexpected shapes (n_in %d, in0 %d, out %d, ws %zu); nothing launched\n", n_in, n_in > 0 ? in_sizes[0] : -1, out_size, ws_size); grid = -1; return; }
        int dev = 0, cus = 0, per_cu = 0;
        if (hipGetDevice(&dev) != hipSuccess || hipDeviceGetAttribute(&cus, hipDeviceAttributeMultiprocessorCount, dev) != hipSuccess) { grid = -1; return; }
        if (hipFuncSetAttribute((const void*)fwd, hipFuncAttributeMaxDynamicSharedMemorySize, LDS_BYTES) != hipSuccess) { grid = -1; return; }
        if (hipOccupancyMaxActiveBlocksPerMultiprocessor(&per_cu, (const void*)fwd, NTHR, LDS_BYTES) != hipSuccess || per_cu < 1) { fprintf(stderr, "kernel_launch: occupancy query says %d\n", per_cu); }
        (void)hipGetLastError();
        grid = cus;
    }
    if (grid < 0) return;
    (void)hipMemsetAsync((char*)d_ws + WS_CTL, 0, CTL_ZERO_BYTES, stream);
    Args a{};
    for (int i = 0; i < 22; ++i) a.in[i] = (const float*)d_in[i];
    a.out = (float*)d_out; a.ws = (unsigned char*)d_ws;
#if MK_ONE_LAUNCH
    a.ph_lo = 0; a.ph_hi = NPHASE;
    hipLaunchKernelGGL(fwd, dim3(grid), dim3(NTHR), LDS_BYTES, stream, a);
#else
    for (int p = 0; p < NPHASE; ++p) { a.ph_lo = p; a.ph_hi = p + 1; hipLaunchKernelGGL(fwd, dim3(grid), dim3(NTHR), LDS_BYTES, stream, a); }
#endif
}
```

```cpp
#include <hip/hip_runtime.h>
#include <cstdio>
#include <cstdint>

#ifndef FAST_DENSE
#define FAST_DENSE 1
#endif
#ifndef FAST_MOE
#define FAST_MOE 1
#endif
#ifndef NEW_CVT
#define NEW_CVT 1
#endif
#ifndef CVT_IN_P0
#define CVT_IN_P0 0
#endif
#ifndef MOE1_FP8
#define MOE1_FP8 1
#endif
#ifndef MOE2_FP8
#define MOE2_FP8 1
#endif
#ifndef F8G
#define F8G 0
#endif
#ifndef F8B
#define F8B 0
#endif
#ifndef F8O
#define F8O 0
#endif
#ifndef INPROJ_LATE_US
#define INPROJ_LATE_US 0
#endif
#ifndef P2_CVT_HI
#define P2_CVT_HI (CVT_STAGGER ? 22 : 11)
#endif
#ifndef EPI_NT
#define EPI_NT 1
#endif
#ifndef FUSE_BR
#define FUSE_BR 1
#endif
#ifndef MOE2_PAIR
#define MOE2_PAIR 1
#endif
#ifndef INPROJ_QUAD
#define ATT_XCD 1
#define CVT_REP 1
#ifndef PROBE_MOE2
#define PROBE_MOE2 0
#ifndef STAGE_OPQ
#define STAGE_OPQ 1
#endif
#ifndef HOIST_W2
#define HOIST_W2 3
#endif
#endif
#ifndef PROBE_ATT
#define PROBE_ATT 0
#endif
#ifndef CVT_DEPTH
#define CVT_DEPTH 2
#endif
#define PROBE_CVT32 0
#ifndef CVT_STAGGER
#define CVT_STAGGER 0
#endif
#define INPROJ_QUAD 0
#endif
#ifndef MK_ONE_LAUNCH
#define MK_ONE_LAUNCH 1
#endif

#define GAS __attribute__((address_space(1)))
#define LAS __attribute__((address_space(3)))
typedef unsigned short bf16;
typedef float f32x4 __attribute__((ext_vector_type(4)));
typedef float f32x16 __attribute__((ext_vector_type(16)));
typedef short bf16x8 __attribute__((ext_vector_type(8)));
typedef short s16x4 __attribute__((ext_vector_type(4)));
typedef unsigned u32x4 __attribute__((ext_vector_type(4)));
typedef unsigned u32x2 __attribute__((ext_vector_type(2)));
typedef GAS unsigned gu32;

constexpr int NB = 16, SEQ = 2048, DM = 1024, T = NB * SEQ;
constexpr int INW = 4352;
constexpr int PLD = INW + 64;
constexpr int C_QA = 0, C_KA = 512, C_VA = 640, C_QB = 768, C_KB = 1280, C_VB = 1792, C_GA = 2304, C_GB = 3328;
constexpr int NE = 256, TOPK = 8, EDIM = 256;
constexpr int NASSIGN = T * TOPK;
constexpr int PADCAP = NASSIGN + NE * 256;
constexpr int NROWS_PAD = PADCAP + T;
constexpr int SH_TILE0 = PADCAP / 256;
constexpr float RMS_EPS = 1e-6f;
constexpr float LOG2E = 1.4426950408889634f;
constexpr float Y8_SCALE = 8.0f;
constexpr float ATT8_SCALE = 4.0f, MRG8_SCALE = 8.0f;
constexpr float HID8_SCALE = 4.0f;
constexpr float W8_SCALE = 64.0f;
constexpr int NWAVES = 8, NTHR = 512;
constexpr int LDS_BYTES = 147456;

constexpr size_t MiB = 1u << 20;
constexpr size_t WS_CTL = 0, CTL_ZERO_BYTES = 1 * MiB;
constexpr size_t WS_MOD = 1 * MiB;
constexpr size_t WS_BB = 2 * MiB;
constexpr size_t WS_TILEE = 3 * MiB;
constexpr size_t WS_WIN = 4 * MiB;
constexpr size_t WS_WIN8 = 9 * MiB;
constexpr size_t WS_WA = 13 * MiB, WS_WB = 14 * MiB, WS_WOUT = 15 * MiB, WS_WR = 17 * MiB;
constexpr size_t WS_WD = 20 * MiB;
constexpr size_t WS_WGU = 149 * MiB;
constexpr size_t WS_Y = 149 * MiB;
constexpr size_t WS_PROJ = 400 * MiB;
constexpr size_t WS_H2F8 = 564 * MiB;
constexpr size_t WS_XMID = 500 * MiB;
constexpr size_t WS_A1 = 678 * MiB;
constexpr size_t WS_A2 = 742 * MiB;
constexpr size_t WS_A3 = 806 * MiB;
constexpr size_t WS_IDX = 982 * MiB, WS_WT = 983 * MiB, WS_RANK = 984 * MiB, WS_POS = 985 * MiB;
constexpr size_t WS_TOKP = 986 * MiB, WS_YPOS = 988 * MiB, WS_WPAD = 990 * MiB, WS_END = 992 * MiB;
static_assert(WS_WD + (size_t)257 * 1024 * 256 * 2 <= WS_WGU, "wd");
static_assert(WS_WGU + (size_t)257 * 512 * 1024 * (MOE1_FP8 ? 1 : 2) <= WS_PROJ, "wgu");
static_assert(WS_PROJ + (size_t)T * PLD * 2 <= WS_A1, "proj");
static_assert(WS_Y + (size_t)(NASSIGN + T + 1) * 1024 <= WS_XMID, "y");
static_assert(WS_A3 + (size_t)NROWS_PAD * 256 * 2 <= WS_IDX, "hid");
static_assert(WS_TOKP + (size_t)NROWS_PAD * 4 <= WS_YPOS && WS_YPOS + (size_t)NROWS_PAD * 4 <= WS_WPAD && WS_WPAD + (size_t)NROWS_PAD * 4 <= WS_END, "pad arrays");
constexpr int CW_BAR = 4096;
constexpr int CW_GCNT = 16384;
constexpr int CW_NRT = 16384 + 256;

__device__ const unsigned char T5B[384] = {
15,15,15,15,15,15,15,15,15,15,15,15,15,15,15,15,15,15,15,15,15,15,15,15,15,15,15,15,15,15,15,15,15,15,15,15,15,15,15,15,15,15,15,15,15,15,15,15,15,15,15,15,15,15,15,15,15,15,15,15,15,15,15,15,15,15,15,15,15,15,15,15,15,15,15,15,15,15,15,15,15,15,15,15,15,15,15,15,15,15,15,15,15,15,15,15,15,15,15,15,15,15,15,15,15,15,15,15,15,15,15,15,15,15,15,15,15,15,15,15,15,15,15,15,15,15,15,15,15,15,15,15,15,15,15,15,15,15,15,15,15,15,15,15,15,15,15,15,15,15,15,15,15,15,15,15,15,15,15,15,15,15,15,15,15,14,14,14,14,14,14,14,14,14,14,14,14,14,14,14,14,14,14,14,14,14,14,14,14,14,14,14,13,13,13,13,13,13,13,13,13,13,13,13,13,13,13,13,13,13,12,12,12,12,12,12,12,12,12,12,12,12,12,12,11,11,11,11,11,11,11,11,11,10,10,10,10,10,10,10,9,9,9,9,8,8,8,8,7,6,5,4,3,2,1,0,17,18,19,20,21,22,23,24,24,24,24,25,25,25,25,26,26,26,26,26,26,26,27,27,27,27,27,27,27,27,27,28,28,28,28,28,28,28,28,28,28,28,28,28,28,29,29,29,29,29,29,29,29,29,29,29,29,29,29,29,29,29,29,30,30,30,30,30,30,30,30,30,30,30,30,30,30,30,30,30,30,30,30,30,30,30,30,30,30,30,31,31,31,31,31,31,31,31,31,31,31,31,31,31,31,31,31,31,31,31,31,31,31,31,31,31,31,31,31,31,31,31,31,31,31,31,31,0};

#define LDS_WAIT() asm volatile("s_waitcnt lgkmcnt(0)" ::: "memory")
__device__ __forceinline__ unsigned f2bf(float f) { unsigned u = __builtin_bit_cast(unsigned, f); return (u + 0x7fffu + ((u >> 16) & 1u)) >> 16; }
__device__ __forceinline__ unsigned pk2(float lo, float hi) { return f2bf(lo) | (f2bf(hi) << 16); }
__device__ __forceinline__ float bf2f(unsigned short b) { return __builtin_bit_cast(float, (unsigned)b << 16); }
__device__ __forceinline__ float bflo(unsigned w) { return __builtin_bit_cast(float, w << 16); }
__device__ __forceinline__ float bfhi(unsigned w) { return __builtin_bit_cast(float, w & 0xffff0000u); }
__device__ __forceinline__ float clamp8(float v) { return __builtin_amdgcn_fmed3f(v, -448.0f, 448.0f); }
__device__ __forceinline__ float ex2(float x) { return __builtin_amdgcn_exp2f(x); }
__device__ __forceinline__ float lg2(float x) { return __builtin_amdgcn_logf(x); }
__device__ __forceinline__ float sigmoidf_(float x) { return __builtin_amdgcn_rcpf(1.0f + ex2(-x * LOG2E)); }
__device__ __forceinline__ float wave_sum(float v) {
#pragma unroll
    for (int o = 1; o < 64; o <<= 1) v += __shfl_xor(v, o);
    return v;
}
__device__ __forceinline__ int crow(int r, int hi) { return (r & 3) + 8 * (r >> 2) + 4 * hi; }
__device__ __forceinline__ s16x4 vtr(const LAS unsigned char* p) {
    typedef short v4i16_t __attribute__((ext_vector_type(4)));
    return __builtin_bit_cast(s16x4, __builtin_amdgcn_ds_read_tr16_b64_v4i16((LAS v4i16_t*)p));
}

#define XB_TMO      128
#define XB_XCNT(j)  (256  + 64 * (j))
#define XB_XSUB(j)  (1280 + 64 * (j))
#define XB_XGEN(j)  (2304 + 64 * (j))
#define XB_TOP      3328
#define XB_TOPGEN   3392
#define XCD_BAR_WORDS 3456
#define XB_SPIN_CAP (1u << 18)
__device__ __forceinline__ unsigned xb_ld(unsigned* p)              { return __hip_atomic_load(p, __ATOMIC_RELAXED, __HIP_MEMORY_SCOPE_AGENT); }
__device__ __forceinline__ unsigned xb_add(unsigned* p, unsigned v) { return __hip_atomic_fetch_add(p, v, __ATOMIC_RELAXED, __HIP_MEMORY_SCOPE_AGENT); }
__device__ __forceinline__ unsigned xb_xcc_id() { return (unsigned)__builtin_amdgcn_s_getreg((3 << 11) | 20) & 0xFu; }
#define XB_SPIN(cond, bar) do { unsigned _sp = 0; while (cond) { __builtin_amdgcn_s_sleep(1); \
    if ((++_sp & 255u) == 0u) { if (xb_ld(&(bar)[XB_TMO])) break; if (_sp > XB_SPIN_CAP) { atomicAdd(&(bar)[XB_TMO], 1u); break; } } } } while (0)
struct XcdBarrier { unsigned* bar; unsigned x; volatile LAS unsigned* st; };
__device__ __forceinline__ XcdBarrier xcd_barrier_post(unsigned* bar, volatile LAS unsigned* st) {
    XcdBarrier b; b.bar = bar; b.x = xb_xcc_id(); b.st = st;
    if (threadIdx.x == 0) (void)xb_add(&bar[XB_XCNT(b.x)], 1u);
    return b;
}
__device__ __forceinline__ void xcd_barrier_complete(unsigned* bar, unsigned x, unsigned& nloc, unsigned& nx) {
    const unsigned G = gridDim.x * gridDim.y * gridDim.z;
    unsigned sum, cnt, mine, sp = 0u;
    for (;;) {
        sum = 0u; cnt = 0u; mine = 0u;
#pragma unroll
        for (unsigned j = 0; j < 16; ++j) { const unsigned c = xb_ld(&bar[XB_XCNT(j)]); sum += c; cnt += (c > 0u) ? 1u : 0u; mine = (j == x) ? c : mine; }
        if (sum == G) break;
        __builtin_amdgcn_s_sleep(1);
        if ((++sp & 255u) == 0u) { if (xb_ld(&bar[XB_TMO])) break; if (sp > XB_SPIN_CAP) { atomicAdd(&bar[XB_TMO], 1u); break; } }
    }
    nloc = mine > 0u ? mine : 1u; nx = cnt > 0u ? cnt : 1u;
}
__device__ __forceinline__ void xcd_barrier(const XcdBarrier& b) {
    asm volatile("s_waitcnt vmcnt(0)" ::: "memory");
    __syncthreads();
    if (threadIdx.x == 0) {
        unsigned* bar = b.bar;
        __builtin_amdgcn_s_waitcnt(0);
        unsigned nloc = b.st[0], nx = b.st[1];
        if (nloc == 0u) { xcd_barrier_complete(bar, b.x, nloc, nx); b.st[0] = nloc; b.st[1] = nx; }
        const unsigned old = xb_add(&bar[XB_XSUB(b.x)], 1u);
        const unsigned gen = old / nloc;
        if (old + 1u == (gen + 1u) * nloc) {
            __builtin_amdgcn_fence(__ATOMIC_RELEASE, "agent");
            asm volatile("s_waitcnt vmcnt(0)" ::: "memory");
            const unsigned og = xb_add(&bar[XB_TOP], 1u);
            const unsigned tg = og / nx;
            if (og + 1u == (tg + 1u) * nx) xb_add(&bar[XB_TOPGEN], 1u);
            else XB_SPIN(xb_ld(&bar[XB_TOPGEN]) == tg, bar);
            __builtin_amdgcn_fence(__ATOMIC_ACQUIRE, "agent");
            xb_add(&bar[XB_XGEN(b.x)], 1u);
            asm volatile("s_waitcnt vmcnt(0)" ::: "memory");
        } else {
            XB_SPIN(xb_ld(&bar[XB_XGEN(b.x)]) == gen, bar);
            __builtin_amdgcn_fence(__ATOMIC_ACQUIRE, "agent");
            asm volatile("s_waitcnt vmcnt(0)" ::: "memory");
        }
    }
    __syncthreads();
}

__device__ __forceinline__ void xcd_arrive(const XcdBarrier& b) {
    asm volatile("s_waitcnt vmcnt(0)" ::: "memory");
    __syncthreads();
    if (threadIdx.x == 0) {
        unsigned* bar = b.bar;
        __builtin_amdgcn_s_waitcnt(0);
        unsigned nloc = b.st[0], nx = b.st[1];
        if (nloc == 0u) { xcd_barrier_complete(bar, b.x, nloc, nx); b.st[0] = nloc; b.st[1] = nx; }
        const unsigned old = xb_add(&bar[XB_XSUB(b.x)], 1u);
        const unsigned gen = old / nloc;
        unsigned role = 0u, tg = 0u;
        if (old + 1u == (gen + 1u) * nloc) {
            __builtin_amdgcn_fence(__ATOMIC_RELEASE, "agent");
            asm volatile("s_waitcnt vmcnt(0)" ::: "memory");
            const unsigned og = xb_add(&bar[XB_TOP], 1u);
            tg = og / nx; role = (og + 1u == (tg + 1u) * nx) ? 2u : 1u;
        }
        b.st[2] = gen; b.st[3] = tg; b.st[4] = role;
    }
}
__device__ __forceinline__ void xcd_wait(const XcdBarrier& b) {
    if (threadIdx.x == 0) {
        unsigned* bar = b.bar; const unsigned gen = b.st[2], tg = b.st[3], role = b.st[4];
        if (role != 0u) {
            if (role == 2u) xb_add(&bar[XB_TOPGEN], 1u);
            else XB_SPIN(xb_ld(&bar[XB_TOPGEN]) == tg, bar);
            __builtin_amdgcn_fence(__ATOMIC_ACQUIRE, "agent");
            xb_add(&bar[XB_XGEN(b.x)], 1u);
            asm volatile("s_waitcnt vmcnt(0)" ::: "memory");
        } else {
            XB_SPIN(xb_ld(&bar[XB_XGEN(b.x)]) == gen, bar);
            __builtin_amdgcn_fence(__ATOMIC_ACQUIRE, "agent");
            asm volatile("s_waitcnt vmcnt(0)" ::: "memory");
        }
    }
    __syncthreads();
}

struct Ctx {
    LAS unsigned char* lds;
    int tid, lane, wave, G, blk;
    float* out; unsigned char* ws;
    __device__ __forceinline__ const float* in(int i) const {
#if defined(__HIP_DEVICE_COMPILE__)
        const void* k = (const void*)__builtin_amdgcn_kernarg_segment_ptr(); asm volatile("" : "+s"(k));
        const GAS float* g = ((const GAS float* const*)k)[i]; return (const float*)g;
#else
        return nullptr;
#endif
    }
    __device__ __forceinline__ int karg_int(int idx) const {
#if defined(__HIP_DEVICE_COMPILE__)
        const void* k = (const void*)__builtin_amdgcn_kernarg_segment_ptr(); asm volatile("" : "+s"(k));
        return ((const GAS int*)k)[idx];
#else
        return 0;
#endif
    }
};

__device__ __forceinline__ void sg_mainloop(LAS unsigned char* lds, const char* pa0, const char* pa1, const char* pb0, const char* pb1, const char* pb2, const char* pb3,
                                            int K, f32x16 (&acc)[2][2]) {
    const int tid = threadIdx.x, lane = tid & 63, wave = tid >> 6, r32 = lane & 31, hi = lane >> 5, wm = wave >> 2, wn = wave & 3;
#pragma unroll
    for (int a = 0; a < 2; ++a)
#pragma unroll
        for (int b = 0; b < 2; ++b)
#pragma unroll
            for (int r = 0; r < 16; ++r) acc[a][b][r] = 0.f;
    const int prow = tid >> 3, pch = tid & 7;
    const unsigned wa0 = pch * 2048 + prow * 16, wa1 = pch * 2048 + (prow + 64) * 16;
    const unsigned wb0 = 16384 + pch * 4096 + prow * 16;
    u32x4 va0, va1, vb0, vb1, vb2, vb3;
    va0 = *(const u32x4*)pa0; va1 = *(const u32x4*)pa1; vb0 = *(const u32x4*)pb0; vb1 = *(const u32x4*)pb1; vb2 = *(const u32x4*)pb2; vb3 = *(const u32x4*)pb3;
    for (int k0 = 0; k0 < K; k0 += 64) {
        __syncthreads();
        *(LAS u32x4*)(lds + wa0) = va0; *(LAS u32x4*)(lds + wa1) = va1;
        *(LAS u32x4*)(lds + wb0) = vb0; *(LAS u32x4*)(lds + wb0 + 1024) = vb1; *(LAS u32x4*)(lds + wb0 + 2048) = vb2; *(LAS u32x4*)(lds + wb0 + 3072) = vb3;
        __syncthreads();
        if (k0 + 64 < K) {
            const int o = (k0 + 64) * 2;
            va0 = *(const u32x4*)(pa0 + o); va1 = *(const u32x4*)(pa1 + o); vb0 = *(const u32x4*)(pb0 + o); vb1 = *(const u32x4*)(pb1 + o); vb2 = *(const u32x4*)(pb2 + o); vb3 = *(const u32x4*)(pb3 + o);
        }
#pragma unroll
        for (int ks = 0; ks < 4; ++ks) {
            bf16x8 af[2], bfv[2];
#pragma unroll
            for (int mt = 0; mt < 2; ++mt) af[mt] = *(const LAS bf16x8*)(lds + (2 * ks + hi) * 2048 + (wm * 64 + mt * 32 + r32) * 16);
#pragma unroll
            for (int j = 0; j < 2; ++j) bfv[j] = *(const LAS bf16x8*)(lds + 16384 + (2 * ks + hi) * 4096 + (j * 128 + wn * 32 + r32) * 16);
#pragma unroll
            for (int mt = 0; mt < 2; ++mt)
#pragma unroll
                for (int j = 0; j < 2; ++j) acc[mt][j] = __builtin_amdgcn_mfma_f32_32x32x16_bf16(bfv[j], af[mt], acc[mt][j], 0, 0, 0);
        }
    }
}


namespace pg8 {
constexpr int BM = 256, BK = 64, HALF = 128, HTB = HALF * BK * 2, NXCD = 8, WGM = 8;
__host__ __device__ __forceinline__ int lds_byte(int r, int c) { const int st = (r >> 4) * 2 + (c >> 5), rr = r & 15, cc = c & 31, ob = rr * 64 + cc * 2; return st * 1024 + (ob ^ (((ob >> 9) & 1) << 5)); }
__host__ __device__ __forceinline__ void stage_rc(int b, int& R, int& C) { const int st = b / 1024, sb = b % 1024, swz = sb ^ (((sb >> 9) & 1) << 5); R = (st >> 1) * 16 + swz / 64; C = (st & 1) * 32 + (swz % 64) / 2; }
__host__ __device__ __forceinline__ int perm32(int rho) { const int n = rho >> 4, i = rho & 15; return 8 * (i >> 2) + 4 * n + (i & 3); }
struct Unit { int pm, pn, e; const LAS unsigned char* meta; };
__device__ __forceinline__ unsigned cvt_pk_bf16(float lo, float hi) { unsigned r; asm volatile("v_cvt_pk_bf16_f32 %0, %1, %2" : "=v"(r) : "v"(lo), "v"(hi)); return r; }

template <class Epi, class Sched, bool ALIGN_EPI, bool F8 = false, int SEGN = 1>
__device__ __forceinline__ void gemm_phase(LAS unsigned char* lds, const int K, const Sched& S, const Epi& E) {
    const int tid = threadIdx.x, wid = __builtin_amdgcn_readfirstlane(tid >> 6), lane = tid & 63, wr = wid >> 2, wc = wid & 3, fr = lane & 15, fq = lane >> 4;
    const int nt = K / BK;
    constexpr bool HOIST = HOIST_W2 == 3 || (HOIST_W2 && Sched::META == 0);
    constexpr bool ALLR = [] { if constexpr (SEGN > 1) return (bool)(HOIST_W2 == 2 && Epi::ALLTRIPS); else return false; }();
    int Rr[2], Cc[2]; unsigned voffB[2];
#pragma unroll
    for (int i = 0; i < 2; ++i) { stage_rc(tid * 16 + i * 8192, Rr[i], Cc[i]); const int R = Rr[i];
        const int Rb = (int)Epi::PERM == 1 ? ((R & ~31) + perm32(R & 31)) : (int)Epi::PERM == 2 ? (64 * (R >> 5) + 16 * ((R >> 2) & 3) + 4 * ((R >> 4) & 1) + (R & 3)) :
                       (int)Epi::PERM == 3 ? (64 * (R >> 5) + 8 * ((R >> 2) & 3) + 4 * ((R >> 4) & 1) + (R & 3)) : R;
        voffB[i] = (unsigned)(Rb * (K / SEGN) + Cc[i]) * 2u; }
    const size_t kstep = (size_t)(BK * 2);
    const size_t hstep = (size_t)((int)Epi::PERM == 2 ? 8 : (int)Epi::PERM == 3 ? 32 : HALF) * (K / SEGN) * 2;
    const unsigned ldsw = (unsigned)wid * 1024u;
    const int aoff = lds_byte(wr * 64 + fr, fq * 8), boff = lds_byte(wc * 32 + fr, fq * 8);
#define PG8_SA(b, h) (((b) * 2 + (h)) * HTB)
#define PG8_SB(b, h) ((4 + (b) * 2 + (h)) * HTB)
#define PG8_STAGE(bufoff, gbase, voff) do { const char* gb_ = (const char*)(gbase); asm volatile("" : "+s"(gb_));     \
        _Pragma("unroll") for (int _i = 0; _i < 2; ++_i) { unsigned vv_ = (voff)[_i]; if (STAGE_OPQ) asm volatile("" : "+v"(vv_));     \
        __builtin_amdgcn_global_load_lds((const unsigned*)(gb_ + vv_), (LAS unsigned*)(lds + (bufoff) + ldsw + _i * 8192), 16, 0, 0); } } while (0)
#define PG8_LDA(dst, b, h) do { _Pragma("unroll") for (int m = 0; m < 4; ++m) _Pragma("unroll") for (int k = 0; k < 2; ++k) dst[m][k] = *(const LAS bf16x8*)(lds + PG8_SA(b, h) + aoff + m * 2048 + k * 1024); } while (0)
#define PG8_LDB(dst, b, h) do { _Pragma("unroll") for (int n = 0; n < 2; ++n) _Pragma("unroll") for (int k = 0; k < 2; ++k) dst[n][k] = *(const LAS bf16x8*)(lds + PG8_SB(b, h) + boff + n * 2048 + k * 1024); } while (0)
#define PG8_MMA(ai, bj, At, Bt) do { __builtin_amdgcn_s_setprio(1); _Pragma("unroll") for (int m = 0; m < 4; ++m) _Pragma("unroll") for (int n = 0; n < 2; ++n) { \
        if constexpr (F8) { typedef int i32x8_ __attribute__((ext_vector_type(8))); typedef int i32x4_ __attribute__((ext_vector_type(4))); \
            const i32x4_ a0_ = __builtin_bit_cast(i32x4_, At[m][0]), a1_ = __builtin_bit_cast(i32x4_, At[m][1]), b0_ = __builtin_bit_cast(i32x4_, Bt[n][0]), b1_ = __builtin_bit_cast(i32x4_, Bt[n][1]); \
            const i32x8_ av_ = {a0_[0], a0_[1], a0_[2], a0_[3], a1_[0], a1_[1], a1_[2], a1_[3]}, bv_ = {b0_[0], b0_[1], b0_[2], b0_[3], b1_[0], b1_[1], b1_[2], b1_[3]}; \
            acc[ai][bj][m][n] = __builtin_amdgcn_mfma_scale_f32_16x16x128_f8f6f4(bv_, av_, acc[ai][bj][m][n], 0, 0, 0, 0, 0, 0); }         \
        else { _Pragma("unroll") for (int k = 0; k < 2; ++k) acc[ai][bj][m][n] = __builtin_amdgcn_mfma_f32_16x16x32_bf16(Bt[n][k], At[m][k], acc[ai][bj][m][n], 0, 0, 0); } } \
        __builtin_amdgcn_s_setprio(0); } while (0)
#define PG8_WAIT_V(n) asm volatile("s_waitcnt vmcnt(" #n ")" ::: "memory")
#define PG8_WAIT_VR(relax) do { if (relax) asm volatile("s_waitcnt vmcnt(%0)" :: "n"(8 + Epi::NSTORE) : "memory"); else asm volatile("s_waitcnt vmcnt(8)" ::: "memory"); } while (0)
#define PG8_WAIT_L(n) asm volatile("s_waitcnt lgkmcnt(" #n ")" ::: "memory")
#define PG8_BAR __builtin_amdgcn_s_barrier()
#define PG8_SCHED __builtin_amdgcn_sched_barrier(0)
#define PG8_LOADVO(dst, u) do { _Pragma("unroll") for (int _h = 0; _h < 2; ++_h) _Pragma("unroll") for (int _i = 0; _i < 2; ++_i) dst[_h][_i] = S.a_off(u, _h * HALF + Rr[_i]) + (unsigned)Cc[_i] * 2u; } while (0)
    Unit cur, nxt; int ui = 0;
    if (!S.next(0, cur)) return;
    f32x4 acc[2][2][4][2];
#pragma unroll
    for (int a = 0; a < 2; ++a)
#pragma unroll
        for (int b = 0; b < 2; ++b)
#pragma unroll
            for (int m = 0; m < 4; ++m)
#pragma unroll
                for (int n = 0; n < 2; ++n) acc[a][b][m][n] = (f32x4){0.f, 0.f, 0.f, 0.f};
    bf16x8 At[4][2], B0[2][2], B1[2][2];
    unsigned vo[2][2], nvo[2][2];
    PG8_LOADVO(vo, cur);
    const char* cA = S.a_ptr(cur); const char* cB = S.b_ptr(cur);
    LAS unsigned char* const metab = lds + 8 * HTB;
    cur.meta = metab;
    if constexpr (Sched::META != 0) S.meta_issue(cur, metab, wid, lane);
    PG8_STAGE(PG8_SB(0, 0), cB, voffB); PG8_STAGE(PG8_SB(0, 1), cB + hstep, voffB); PG8_STAGE(PG8_SA(0, 0), cA, vo[0]); PG8_STAGE(PG8_SA(0, 1), cA, vo[1]);
    if (wr == 1) PG8_BAR;
    PG8_WAIT_V(2); PG8_BAR;
    PG8_STAGE(PG8_SB(1, 0), cB + kstep, voffB); PG8_STAGE(PG8_SA(1, 0), cA + kstep, vo[0]); PG8_STAGE(PG8_SB(1, 1), cB + hstep + kstep, voffB);
    if constexpr (ALLR) { PG8_STAGE(PG8_SA(1, 1), cA + kstep, vo[1]); PG8_WAIT_V(8); PG8_BAR; E.dummy(lane); }
    else { PG8_WAIT_V(6); PG8_BAR; }
    for (;;) {
        const bool has_next = S.next(ui + 1, nxt);
        const char* nA = cA; const char* nB = cB;
        if (has_next) { nA = S.a_ptr(nxt); nB = S.b_ptr(nxt); nxt.meta = metab + ((ui + 1) % 3) * 2048;
            if constexpr (Sched::META != 0) S.meta_issue(nxt, (LAS unsigned char*)nxt.meta, wid, lane);
            else if constexpr (Sched::GATHER) { PG8_LOADVO(nvo, nxt); } }
        const int segT = nt / SEGN;
#pragma nounroll
        for (int t = 0; t < nt; t += 2) {
            const bool last = (t == nt - 2);
            const char* a1 = cA + (size_t)(t + 1) * kstep;
            const char* a2 = last ? nA : cA + (size_t)(t + 2) * kstep; const char* b2 = last ? nB : cB + (size_t)(t + 2) * kstep;
            bool seg_start = false;
            if constexpr (SEGN > 1) {
                const int s1 = ALLR ? (t >> 1) : t / segT, s2 = ALLR ? s1 + 1 : (t + 2) / segT; seg_start = ALLR ? (t > 0) : (t > 0) && (t == s1 * segT);
                a1 = S.a_seg(cur, s1) + (size_t)(t + 1 - s1 * segT) * kstep;
                if (seg_start) { if ((HOIST || ALLR) && Epi::MIDSTORE) PG8_STAGE(PG8_SA(1, 1), a1, vo[1]); E.mid(acc, cur, s1 - 1, wr, wc, fr, fq); if constexpr (ALLR) PG8_SCHED; }
                if (!last) { a2 = S.a_seg(cur, s2) + (size_t)(t + 2 - s2 * segT) * kstep; b2 = S.b_seg(cur, s2) + (size_t)(t + 2 - s2 * segT) * kstep; }
            }
            const char* a3 = a2 + kstep; const char* b3 = b2 + kstep;
            bool relax = ALLR || ((t == 0) && (ui > 0));
            if constexpr (SEGN > 1) { if (Epi::MIDSTORE && seg_start) relax = true; }
            PG8_LDB(B0, 0, 0); PG8_LDB(B1, 0, 1); PG8_SCHED; PG8_LDA(At, 0, 0); if (!ALLR && !(HOIST && relax)) PG8_STAGE(PG8_SA(1, 1), a1, vo[1]);
            if constexpr (Sched::GATHER) { if (last && has_next) {
#pragma unroll
                for (int _h = 0; _h < 2; ++_h)
#pragma unroll
                    for (int _i = 0; _i < 2; ++_i) { if constexpr (Sched::META != 0) { int R2_, C2_; int tid2_ = threadIdx.x; asm volatile("" : "+v"(tid2_)); stage_rc(tid2_ * 16 + _i * 8192, R2_, C2_);
                            vo[_h][_i] = S.meta_off(nxt.meta, _h * HALF + R2_) + (unsigned)C2_ * 2u; } else vo[_h][_i] = nvo[_h][_i]; } } }
            PG8_WAIT_VR(relax); PG8_WAIT_L(0); PG8_BAR; PG8_MMA(0, 0, At, B0); PG8_MMA(0, 1, At, B1); PG8_BAR; PG8_SCHED;
            PG8_LDA(At, 0, 1); PG8_STAGE(PG8_SB(0, 0), b2, voffB); PG8_STAGE(PG8_SB(0, 1), b2 + hstep, voffB); PG8_STAGE(PG8_SA(0, 0), a2, vo[0]);
            PG8_WAIT_VR(relax); PG8_WAIT_L(0); PG8_BAR; PG8_MMA(1, 0, At, B0); PG8_MMA(1, 1, At, B1); PG8_BAR; PG8_SCHED;
            PG8_LDB(B0, 1, 0); PG8_LDB(B1, 1, 1); PG8_SCHED; PG8_LDA(At, 1, 0); PG8_STAGE(PG8_SA(0, 1), a2, vo[1]);
            PG8_WAIT_VR(ALLR || (HOIST && relax)); PG8_WAIT_L(0); PG8_BAR; PG8_MMA(0, 0, At, B0); PG8_MMA(0, 1, At, B1); PG8_BAR; PG8_SCHED;
            PG8_LDA(At, 1, 1); PG8_STAGE(PG8_SB(1, 0), b3, voffB); PG8_STAGE(PG8_SB(1, 1), b3 + hstep, voffB); PG8_STAGE(PG8_SA(1, 0), a3, vo[0]);
            PG8_WAIT_V(8); PG8_WAIT_L(0); PG8_BAR; PG8_MMA(1, 0, At, B0); PG8_MMA(1, 1, At, B1); PG8_BAR; PG8_SCHED;
        }
        if (HOIST || ALLR) PG8_STAGE(PG8_SA(1, 1), nA + kstep, vo[1]);
        if constexpr (ALIGN_EPI) { if (wr == 0) PG8_BAR; }
        E(acc, cur, wr, wc, fr, fq);
        if (!has_next) break;
#pragma unroll
        for (int a = 0; a < 2; ++a)
#pragma unroll
            for (int b = 0; b < 2; ++b)
#pragma unroll
                for (int m = 0; m < 4; ++m)
#pragma unroll
                    for (int n = 0; n < 2; ++n) acc[a][b][m][n] = (f32x4){0.f, 0.f, 0.f, 0.f};
        cur = nxt; cA = nA; cB = nB; ++ui;
        if constexpr (ALIGN_EPI) { if (wr == 1) PG8_BAR; }
    }
    PG8_WAIT_V(0);
    if constexpr (!ALIGN_EPI) { if (wr == 0) PG8_BAR; }
    PG8_BAR;
#undef PG8_SA
#undef PG8_SB
#undef PG8_STAGE
#undef PG8_LDA
#undef PG8_LDB
#undef PG8_MMA
#undef PG8_WAIT_V
#undef PG8_WAIT_VR
#undef PG8_WAIT_L
#undef PG8_BAR
#undef PG8_SCHED
#undef PG8_LOADVO
}

struct DenseSched {
    static constexpr bool GATHER = false; static constexpr int META = 0;
    const char* A; const char* Bt; const char* A2; const char* Bt2; int K; int nM, nN, nwg, G, c, i_lo, i_hi, nseg;
    __device__ __forceinline__ void init(const void* A_, const void* Bt_, int M, int N, int K_, int G_, int c_) { A = (const char*)A_; Bt = (const char*)Bt_; K = K_; nM = M / BM; nN = N / BM; nwg = nM * nN; G = G_; c = c_; i_lo = 0; i_hi = 1 << 30; nseg = 0; }
    __device__ __forceinline__ bool next(int i, Unit& u) const {
        i += i_lo; if (i >= i_hi) return false;
        const long L = (long)i * G + c; if (L >= nwg) return false;
        int wgid = (int)L; { const int q = nwg / NXCD, r = nwg % NXCD, xcd = wgid % NXCD, off = wgid / NXCD; wgid = (xcd < r ? xcd * (q + 1) : r * (q + 1) + (xcd - r) * q) + off; }
        const int nig = WGM * nN, gid = wgid / nig, fm = gid * WGM, gsz = (nM - fm) < WGM ? (nM - fm) : WGM;
        u.pm = fm + ((wgid % nig) % gsz); u.pn = (wgid % nig) / gsz; u.e = 0; return true;
    }
    __device__ __forceinline__ const char* a_ptr(const Unit& u) const { return A + (size_t)u.pm * BM * K * 2; }
    __device__ __forceinline__ const char* b_ptr(const Unit& u) const { return Bt + (size_t)u.pn * (nseg > 0 ? nseg : 1) * BM * K * 2; }
    __device__ __forceinline__ const char* a_seg(const Unit& u, int s) const { return ((nseg == 0 && s) ? A2 : A) + (size_t)u.pm * BM * K * 2; }
    __device__ __forceinline__ const char* b_seg(const Unit& u, int s) const { return nseg == 0 ? (s ? Bt2 : Bt) + (size_t)u.pn * BM * K * 2 : Bt + (size_t)(u.pn * nseg + s) * BM * K * 2; }
    __device__ __forceinline__ unsigned a_off(const Unit&, int row) const { return (unsigned)(row * K) * 2u; }
};
}

__device__ __forceinline__ void tr_item(const float* W, int K, int N, bf16* WT, int k0, int n0, int rb, LAS float* scr, int lane) {
#pragma unroll 8
    for (int i = 0; i < 32; ++i) { const int kk = 2 * i + (lane >> 5); scr[kk * 33 + (lane & 31)] = W[(size_t)(k0 + kk) * N + n0 + (lane & 31)]; }
    LDS_WAIT(); asm volatile("" ::: "memory");
    const int c = lane & 7;
#pragma unroll
    for (int j = 0; j < 4; ++j) { const int n = (lane >> 3) + 8 * j; const LAS float* s = scr + (8 * c) * 33 + n;
        u32x4 o; o.x = pk2(s[0 * 33], s[1 * 33]); o.y = pk2(s[2 * 33], s[3 * 33]); o.z = pk2(s[4 * 33], s[5 * 33]); o.w = pk2(s[6 * 33], s[7 * 33]);
        *(u32x4*)(WT + (size_t)(rb + n) * K + k0 + 8 * c) = o; }
    LDS_WAIT(); asm volatile("" ::: "memory");
}
__device__ __forceinline__ void tr_dense(const float* W, int K, int N, bf16* WT, int item, LAS float* scr, int lane) {
    const int nblk = N / 32, kb = item / nblk, nb = item % nblk;
    tr_item(W, K, N, WT, 64 * kb, 32 * nb, 32 * nb, scr, lane);
}
__device__ __forceinline__ void tr_expert(const Ctx& F, int e, int r, LAS float* scr) {
    const float* wg = (e < NE) ? F.in(16) + (size_t)e * DM * EDIM : F.in(19);
    const float* wu = (e < NE) ? F.in(17) + (size_t)e * DM * EDIM : F.in(20);
    const float* wd = (e < NE) ? F.in(18) + (size_t)e * EDIM * DM : F.in(21);
    bf16* gu = (bf16*)(F.ws + WS_WGU) + (size_t)e * 512 * 1024;
    bf16* dd = (bf16*)(F.ws + WS_WD) + (size_t)e * 1024 * 256;
    if (r < 256) {
        const int up = r >> 7, it = r & 127, kb = it >> 3, nb = it & 7, n0 = 32 * nb;
        const int rb = (n0 >> 7) * 256 + up * 128 + (n0 & 127);
        tr_item(up ? wu : wg, DM, EDIM, gu, 64 * kb, n0, rb, scr, F.lane);
    } else {
        const int it = r - 256, kb = it >> 5, nb = it & 31;
        tr_item(wd, EDIM, DM, dd, 64 * kb, 32 * nb, 32 * nb, scr, F.lane);
    }
}

constexpr int N_GU_ITEMS = 257 * 128, N_D_ITEMS = 257 * 64;
constexpr int CVT_GB = CVT_STAGGER ? 0 : 5 * 2048, CVT_G1 = CVT_STAGGER ? N_GU_ITEMS : CVT_GB + 8 * 2048, CVT_DB = 4 * 2048;
struct CvtItem { const float* W; bf16* WT; int N, K, k0, n0, rb; };
struct CvtBases { const float *g, *u, *d, *gs, *us, *ds; };
__device__ __forceinline__ CvtBases cvt_bases(const Ctx& F) { CvtBases b; b.g = F.in(16); b.u = F.in(17); b.d = F.in(18); b.gs = F.in(19); b.us = F.in(20); b.ds = F.in(21); return b; }
template <bool GU> __device__ __forceinline__ CvtItem cvt_decode(const Ctx& F, const CvtBases& P, int item) {
    CvtItem c;
    if (GU) {
        const int e = item / 128, r = item % 128;
        const int up = r >> 6, kb = (r & 63) >> 2, nb = r & 3, n0 = 64 * nb;
        c.W = up ? ((e < NE) ? P.u + (size_t)e * DM * EDIM : P.us) : ((e < NE) ? P.g + (size_t)e * DM * EDIM : P.gs);
        c.WT = MOE1_FP8 ? (bf16*)((unsigned char*)(F.ws + WS_WGU) + (size_t)e * 512 * 1024) : (bf16*)(F.ws + WS_WGU) + (size_t)e * 512 * 1024;
        c.N = EDIM; c.K = DM; c.k0 = 64 * kb; c.n0 = n0; c.rb = (n0 >> 7) * 256 + up * 128 + (n0 & 127);
    } else {
        const int e = item / 64, it = item % 64, kb = it >> 4, nb = it & 15;
        c.W = (e < NE) ? P.d + (size_t)e * EDIM * DM : P.ds; c.WT = MOE2_FP8 ? (bf16*)((unsigned char*)(F.ws + WS_WD) + (size_t)e * 1024 * 256) : (bf16*)(F.ws + WS_WD) + (size_t)e * 1024 * 256; c.N = DM; c.K = EDIM; c.k0 = 64 * kb; c.n0 = 64 * nb; c.rb = 64 * nb;
    }
    return c;
}
template <bool NT = true, bool F8 = false> __device__ __forceinline__ void cvt_load(const CvtItem& c, f32x4 (&v)[16], int lane) {
    const float* p = c.W + (size_t)(c.k0 + (F8 ? 2 : 1) * (lane >> 4)) * c.N + c.n0 + 4 * (lane & 15);
#pragma unroll
    for (int i = 0; i < 16; ++i) { const int ro = F8 ? 8 * (i >> 1) + (i & 1) : 4 * i; v[i] = NT ? __builtin_nontemporal_load((const f32x4*)(p + (size_t)ro * c.N)) : *(const f32x4*)(p + (size_t)ro * c.N); }
}
template <bool NT = true> __device__ __forceinline__ void cvt_store_f8(const CvtItem& c, const f32x4 (&v)[16], LAS unsigned char* img, int lane) {
    const int kp = lane >> 4, n4 = 4 * (lane & 15);
    LAS unsigned char* wp = img + (n4 >> 5) * 2048 + kp * 64 + (n4 & 31) * 2;
#pragma unroll
    for (int i = 0; i < 8; ++i) { const f32x4 a = v[2 * i] * W8_SCALE, b = v[2 * i + 1] * W8_SCALE; int t0 = 0, t1 = 0;
        t0 = __builtin_amdgcn_cvt_pk_fp8_f32(a.x, b.x, t0, false); t0 = __builtin_amdgcn_cvt_pk_fp8_f32(a.y, b.y, t0, true);
        t1 = __builtin_amdgcn_cvt_pk_fp8_f32(a.z, b.z, t1, false); t1 = __builtin_amdgcn_cvt_pk_fp8_f32(a.w, b.w, t1, true);
        *(LAS u32x2*)(wp + i * 256) = (u32x2){(unsigned)t0, (unsigned)t1}; }
    LDS_WAIT(); asm volatile("" ::: "memory");
    const int g = lane >> 4, q = (lane & 15) >> 2, p = lane & 3, i16 = lane & 15;
    unsigned char* wt = (unsigned char*)c.WT;
#pragma unroll
    for (int s = 0; s < 4; ++s) {
        const LAS unsigned char* rp = img + (s >> 1) * 2048 + (8 * g + q) * 64 + (16 * (s & 1) + 4 * p) * 2;
        const s16x4 lo = vtr(rp), hh = vtr(rp + 256);
        const u32x4 o = __builtin_bit_cast(u32x4, (bf16x8){lo[0], lo[1], lo[2], lo[3], hh[0], hh[1], hh[2], hh[3]});
        if (NT) __builtin_nontemporal_store(o, (u32x4*)(wt + (size_t)(c.rb + 16 * s + i16) * c.K + c.k0 + 16 * g)); else *(u32x4*)(wt + (size_t)(c.rb + 16 * s + i16) * c.K + c.k0 + 16 * g) = o;
    }
    LDS_WAIT(); asm volatile("" ::: "memory");
}
template <bool NT = true> __device__ __forceinline__ void cvt_store(const CvtItem& c, const f32x4 (&v)[16], LAS unsigned char* img, int lane) {
    const int kk0 = lane >> 4, n4 = 4 * (lane & 15);
    LAS unsigned char* wp = img + (n4 >> 5) * 4096 + kk0 * 64 + (n4 & 31) * 2;
#pragma unroll
    for (int i = 0; i < 16; ++i) { u32x2 w; w.x = pk2(v[i].x, v[i].y); w.y = pk2(v[i].z, v[i].w); *(LAS u32x2*)(wp + i * 256) = w; }
    LDS_WAIT(); asm volatile("" ::: "memory");
    const int g = lane >> 4, q = (lane & 15) >> 2, p = lane & 3, i16 = lane & 15;
#pragma unroll
    for (int s = 0; s < 8; ++s) {
        const int oct = 4 * (s & 1) + g, cb = s >> 1;
        const LAS unsigned char* rp = img + (cb >> 1) * 4096 + (8 * oct + q) * 64 + (16 * (cb & 1) + 4 * p) * 2;
        const s16x4 lo = vtr(rp), hh = vtr(rp + 256);
        u32x4 o = __builtin_bit_cast(u32x4, (bf16x8){lo[0], lo[1], lo[2], lo[3], hh[0], hh[1], hh[2], hh[3]});
        if (NT) __builtin_nontemporal_store(o, (u32x4*)(c.WT + (size_t)(c.rb + 16 * cb + i16) * c.K + c.k0 + 8 * oct)); else *(u32x4*)(c.WT + (size_t)(c.rb + 16 * cb + i16) * c.K + c.k0 + 8 * oct) = o;
    }
    LDS_WAIT(); asm volatile("" ::: "memory");
}
template <bool GU> __device__ __forceinline__ void cvt_experts_from1(const Ctx& F, LAS unsigned char* img, int it, const int NGW, const int item_hi) {
    constexpr bool F8 = GU ? (bool)MOE1_FP8 : (bool)MOE2_FP8;
    if (it >= item_hi) return;
    if (it + NGW >= item_hi) {
        f32x4 v1[16]; const CvtBases P1 = cvt_bases(F); const CvtItem c1 = cvt_decode<GU>(F, P1, it); cvt_load<true, F8>(c1, v1, F.lane);
        if (F8) cvt_store_f8(c1, v1, img, F.lane); else cvt_store(c1, v1, img, F.lane);
        return;
    }
    f32x4 va[16], vb[16];
    const CvtBases P = cvt_bases(F);
    CvtItem ca = cvt_decode<GU>(F, P, it), cb;
    cvt_load<true, F8>(ca, va, F.lane);
#if CVT_DEPTH == 3
    if (F8) {
        f32x4 vc[16]; CvtItem cc;
        { const int i1 = it + NGW, i1c = i1 < item_hi ? i1 : it; cb = cvt_decode<GU>(F, P, i1c); cvt_load<true, F8>(cb, vb, F.lane); }
        for (;;) {
            { const int i2 = it + 2 * NGW, i2c = i2 < item_hi ? i2 : it; cc = cvt_decode<GU>(F, P, i2c); cvt_load<true, F8>(cc, vc, F.lane); }
            cvt_store_f8(ca, va, img, F.lane);
            if (it + NGW >= item_hi) break;
            { const int i3 = it + 3 * NGW, i3c = i3 < item_hi ? i3 : it; ca = cvt_decode<GU>(F, P, i3c); cvt_load<true, F8>(ca, va, F.lane); }
            cvt_store_f8(cb, vb, img, F.lane);
            if (it + 2 * NGW >= item_hi) break;
            { const int i4 = it + 4 * NGW, i4c = i4 < item_hi ? i4 : it; cb = cvt_decode<GU>(F, P, i4c); cvt_load<true, F8>(cb, vb, F.lane); }
            cvt_store_f8(cc, vc, img, F.lane);
            if (it + 3 * NGW >= item_hi) break;
            it += 3 * NGW;
        }
        return;
    }
#endif
    for (;;) {
        const int it1 = it + NGW, it1c = it1 < item_hi ? it1 : it;
        cb = cvt_decode<GU>(F, P, it1c); cvt_load<true, F8>(cb, vb, F.lane);
        if (F8) cvt_store_f8(ca, va, img, F.lane); else cvt_store(ca, va, img, F.lane);
        if (it1 >= item_hi) break;
        const int it2 = it1 + NGW, it2c = it2 < item_hi ? it2 : it1;
        ca = cvt_decode<GU>(F, P, it2c); cvt_load<true, F8>(ca, va, F.lane);
        if (F8) cvt_store_f8(cb, vb, img, F.lane); else cvt_store(cb, vb, img, F.lane);
        if (it2 >= item_hi) break;
        it = it2;
    }
}
#ifndef CVT_REP
#define CVT_REP 1
#ifndef PROBE_ATT
#define PROBE_ATT 0
#endif
#ifndef CVT_DEPTH
#define CVT_DEPTH 2
#endif
#endif
template <bool GU> __device__ __forceinline__ void cvt_experts_from(const Ctx& F, LAS unsigned char* img, int it, const int NGW, const int item_hi) {
    if (CVT_REP == 1) cvt_experts_from1<GU>(F, img, it, NGW, item_hi);
    else {
#pragma nounroll
        for (int rep = 0; rep < CVT_REP; ++rep) { int r = rep; asm volatile("" : "+s"(r)); cvt_experts_from1<GU>(F, img, it + 0 * r, NGW, item_hi); }
    }
}
template <bool GU> __device__ __forceinline__ void cvt_experts(const Ctx& F, LAS unsigned char* img, const int item_lo, const int item_hi) {
    cvt_experts_from<GU>(F, img, item_lo + F.blk * NWAVES + F.wave, F.G * NWAVES, item_hi);
}
__device__ __forceinline__ void phase_prologue(const Ctx& F) { const float* const p_c = F.in(1); const float* const p_wada = F.in(2); const float* const p_bada = F.in(3); const float* const p_win = F.in(6); const float* const p_wba = F.in(9); const float* const p_wbb = F.in(10); const float* const p_wout = F.in(11); const float* const p_wr = F.in(14);
    {
        LAS float* sc = (LAS float*)(F.lds + 69632);
        LAS float* red = (LAS float*)(F.lds);
        float* mod = (float*)(F.ws + WS_MOD);
        for (int it = F.blk; it < 96; it += F.G) {
            __syncthreads();
            for (int i = F.tid; i < 16 * 1024; i += NTHR) { const float v = p_c[i]; sc[i] = v * sigmoidf_(v); }
            __syncthreads();
            const int col = it * 64 + F.lane, kb = F.wave * 128;
            float acc[16];
#pragma unroll
            for (int b = 0; b < 16; ++b) acc[b] = 0.f;
            for (int k = 0; k < 128; k += 4) {
                float w0 = p_wada[(size_t)(kb + k) * 6144 + col], w1 = p_wada[(size_t)(kb + k + 1) * 6144 + col], w2 = p_wada[(size_t)(kb + k + 2) * 6144 + col], w3 = p_wada[(size_t)(kb + k + 3) * 6144 + col];
#pragma unroll
                for (int b = 0; b < 16; ++b) { const f32x4 s = *(const LAS f32x4*)(sc + b * 1024 + kb + k); acc[b] += s.x * w0 + s.y * w1 + s.z * w2 + s.w * w3; }
            }
#pragma unroll
            for (int b = 0; b < 16; ++b) red[(F.wave * 16 + b) * 64 + F.lane] = acc[b];
            __syncthreads();
            for (int o = F.tid; o < 1024; o += NTHR) { const int b = o >> 6, l = o & 63; float s = 0.f;
#pragma unroll
                for (int w = 0; w < 8; ++w) s += red[(w * 16 + b) * 64 + l];
                mod[b * 6144 + it * 64 + l] = s + p_bada[it * 64 + l]; }
        }
        __syncthreads();
    }
    const int gw = F.blk * NWAVES + F.wave, NGW = F.G * NWAVES;
    constexpr int D_IN = 16 * 68, D_A = 8 * 16, D_OUT = 16 * 16, D_R = 16 * 4;
    constexpr int NDENSE = D_IN + 2 * D_A + D_OUT + D_R;
    for (int it = gw; it < NDENSE; it += NGW) {
        int r = it; CvtItem c;
        if (r < D_IN) { c.W = p_win; c.WT = (bf16*)(F.ws + WS_WIN); c.N = INW; c.K = DM; c.k0 = 64 * (r / 68); c.n0 = 64 * (r % 68); }
        else if ((r -= D_IN) < D_A) { c.W = p_wba; c.WT = (bf16*)(F.ws + WS_WA); c.N = DM; c.K = 512; c.k0 = 64 * (r / 16); c.n0 = 64 * (r % 16); }
        else if ((r -= D_A) < D_A) { c.W = p_wbb; c.WT = (bf16*)(F.ws + WS_WB); c.N = DM; c.K = 512; c.k0 = 64 * (r / 16); c.n0 = 64 * (r % 16); }
        else if ((r -= D_A) < D_OUT) { c.W = p_wout; c.WT = (bf16*)(F.ws + WS_WOUT); c.N = DM; c.K = DM; c.k0 = 64 * (r / 16); c.n0 = 64 * (r % 16); }
        else { r -= D_OUT; c.W = p_wr; c.WT = (bf16*)(F.ws + WS_WR); c.N = NE; c.K = DM; c.k0 = 64 * (r / 4); c.n0 = 64 * (r % 4); }
        c.rb = c.n0;
        const bool f8 = (F8G && it >= 16 * 36 && it < D_IN) || (F8B && it >= D_IN && it < D_IN + 2 * D_A) || (F8O && it >= D_IN + 2 * D_A && it < D_IN + 2 * D_A + D_OUT);
        if (F8G && it < D_IN) { c.k0 = 64 * (it % 16); c.n0 = 64 * (it / 16); c.rb = c.n0; if (f8) { c.WT = (bf16*)(F.ws + WS_WIN8); c.rb = c.n0 - C_GA; } }
        f32x4 v[16];
        if (f8) { cvt_load<false, true>(c, v, F.lane); cvt_store_f8<false>(c, v, F.lds + F.wave * 8448, F.lane); }
        else { cvt_load<false>(c, v, F.lane); cvt_store<false>(c, v, F.lds + F.wave * 8448, F.lane); }
    }
    if (NEW_CVT && CVT_IN_P0) { cvt_experts<true>(F, F.lds + F.wave * 8448, 0, N_GU_ITEMS); cvt_experts<false>(F, F.lds + F.wave * 8448, 0, N_D_ITEMS); }
    if (PROBE_CVT32 == 1 && ((F.blk >> 3) & 7) == 0) cvt_experts_from<true>(F, F.lds + F.wave * 8448, F.blk * NWAVES + F.wave, 2048, 8 * 2048);
    if (PROBE_CVT32 == 2) cvt_experts_from<true>(F, F.lds + F.wave * 8448, F.blk * NWAVES + F.wave, 2048, 8 * 2048);
}

__device__ __forceinline__ void phase_h(const Ctx& F) { const float* const p_x = F.in(0); const float* const p_gpm = F.in(4);
    const int gw = F.blk * NWAVES + F.wave, NGW = F.G * NWAVES;
    const float* mod = (const float*)(F.ws + WS_MOD);
    bf16* h = (bf16*)(F.ws + WS_A1);
    for (int ch = gw; ch < T / 16; ch += NGW) {
        const int row0 = ch * 16, b = row0 / SEQ;
        f32x4 gs[4], sh[4];
#pragma unroll
        for (int j = 0; j < 4; ++j) { const int col = 4 * F.lane + 256 * j;
            const f32x4 g = *(const f32x4*)(p_gpm + col), s1 = *(const f32x4*)(mod + b * 6144 + 1024 + col);
            gs[j] = g * (s1 + 1.0f); sh[j] = *(const f32x4*)(mod + b * 6144 + col); }
        for (int rr = 0; rr < 16; ++rr) {
            const float* xr = p_x + (size_t)(row0 + rr) * DM;
            f32x4 v[4]; float s = 0.f;
#pragma unroll
            for (int j = 0; j < 4; ++j) { v[j] = *(const f32x4*)(xr + 4 * F.lane + 256 * j); s += (v[j].x * v[j].x + v[j].y * v[j].y) + (v[j].z * v[j].z + v[j].w * v[j].w); }
            const float rinv = 1.0f / sqrtf(wave_sum(s) * (1.f / DM) + RMS_EPS);
            bf16* orow = h + (size_t)(row0 + rr) * DM;
#pragma unroll
            for (int j = 0; j < 4; ++j) { const f32x4 o = v[j] * rinv * gs[j] + sh[j]; u32x2 w; w.x = pk2(o.x, o.y); w.y = pk2(o.z, o.w); *(u32x2*)(orow + 4 * F.lane + 256 * j) = w;
                if (F8G) { int t8 = 0; t8 = __builtin_amdgcn_cvt_pk_fp8_f32(o.x, o.y, t8, false); t8 = __builtin_amdgcn_cvt_pk_fp8_f32(o.z, o.w, t8, true); *(unsigned*)(F.ws + WS_A3 + (size_t)(row0 + rr) * DM + 4 * F.lane + 256 * j) = (unsigned)t8; } }
        }
    }
}

template <int MODE> __device__ __forceinline__ void phase_dense(const Ctx& F) {
    const bf16* A; const bf16* Bt; int K, N;
    if (MODE == 0) { A = (const bf16*)(F.ws + WS_A1); Bt = (const bf16*)(F.ws + WS_WIN); K = 1024; N = INW; }
    else if (MODE == 1) { A = (const bf16*)(F.ws + WS_A2); Bt = (const bf16*)(F.ws + WS_WA); K = 512; N = 1024; }
    else if (MODE == 2) { A = (const bf16*)(F.ws + WS_A2) + (size_t)T * 512; Bt = (const bf16*)(F.ws + WS_WB); K = 512; N = 1024; }
    else if (MODE == 3) { A = (const bf16*)(F.ws + WS_A3); Bt = (const bf16*)(F.ws + WS_WOUT); K = 1024; N = 1024; }
    else { A = (const bf16*)(F.ws + WS_A2); Bt = (const bf16*)(F.ws + WS_WR); K = 1024; N = 256; }
    const int nN = N / 256, nU = (T / 128) * nN;
    const int r32 = F.lane & 31, hi = F.lane >> 5, wm = F.wave >> 2, wn = F.wave & 3;
    const int prow = F.tid >> 3, pch = F.tid & 7;
    bf16* proj = (bf16*)(F.ws + WS_PROJ);
    for (int u = F.blk; u < nU; u += F.G) {
        const int pm = u / nN, pn = u % nN;
        const char* pa0 = (const char*)(A + (size_t)(pm * 128 + prow) * K) + pch * 16;
        const char* pa1 = pa0 + (size_t)64 * K * 2;
        const char* pb0 = (const char*)(Bt + (size_t)(pn * 256 + prow) * K) + pch * 16;
        const size_t bs = (size_t)64 * K * 2;
        f32x16 acc[2][2];
        sg_mainloop(F.lds, pa0, pa1, pb0, pb0 + bs, pb0 + 2 * bs, pb0 + 3 * bs, K, acc);
#pragma unroll
        for (int mt = 0; mt < 2; ++mt) {
            const size_t row = (size_t)pm * 128 + wm * 64 + mt * 32 + r32;
#pragma unroll
            for (int j = 0; j < 2; ++j)
#pragma unroll
                for (int rg = 0; rg < 4; ++rg) {
                    const int col = pn * 256 + j * 128 + wn * 32 + 8 * rg + 4 * hi;
                    float v0 = acc[mt][j][4 * rg], v1 = acc[mt][j][4 * rg + 1], v2 = acc[mt][j][4 * rg + 2], v3 = acc[mt][j][4 * rg + 3];
                    if (MODE == 0) { u32x2 w; w.x = pk2(v0, v1); w.y = pk2(v2, v3); *(u32x2*)(proj + row * PLD + col) = w; }
                    else if (MODE == 1 || MODE == 2) {
                        const u32x2 g = *(const u32x2*)(proj + row * PLD + (MODE == 1 ? C_GA : C_GB) + col);
                        v0 *= sigmoidf_(bflo(g.x)); v1 *= sigmoidf_(bfhi(g.x)); v2 *= sigmoidf_(bflo(g.y)); v3 *= sigmoidf_(bfhi(g.y));
                        bf16* mp = (bf16*)(F.ws + WS_A3) + row * DM + col;
                        if (MODE == 2) { const u32x2 m = *(const u32x2*)mp; v0 += bflo(m.x); v1 += bfhi(m.x); v2 += bflo(m.y); v3 += bfhi(m.y); }
                        u32x2 w; w.x = pk2(v0, v1); w.y = pk2(v2, v3); *(u32x2*)mp = w;
                    } else if (MODE == 3) { u32x2 w; w.x = pk2(v0, v1); w.y = pk2(v2, v3); *(u32x2*)((bf16*)(F.ws + WS_A1) + row * DM + col) = w; }
                    else { *(f32x4*)((float*)(F.ws + WS_A1) + row * NE + col) = (f32x4){v0, v1, v2, v3}; }
                }
        }
    }
}


namespace pg8 {
struct EpiStoreBf16 {
    static constexpr int PERM = 1, NSTORE = 16; bf16* O; int ldc; int coff; float scale;
    __device__ __forceinline__ void operator()(const f32x4 (&acc)[2][2][4][2], const Unit& u, int wr, int wc, int fr, int fq) const {
        const int row0 = u.pm * BM + wr * 64 + fr, col0 = coff + u.pn * BM + wc * 32 + 8 * fq;
#pragma unroll
        for (int ai = 0; ai < 2; ++ai)
#pragma unroll
            for (int m = 0; m < 4; ++m) { bf16* rowp = O + (size_t)(row0 + ai * HALF + m * 16) * ldc + col0;
#pragma unroll
                for (int bj = 0; bj < 2; ++bj) { const f32x4 v0 = acc[ai][bj][m][0] * scale, v1 = acc[ai][bj][m][1] * scale;
                    u32x4 w; w.x = cvt_pk_bf16(v0[0], v0[1]); w.y = cvt_pk_bf16(v0[2], v0[3]); w.z = cvt_pk_bf16(v1[0], v1[1]); w.w = cvt_pk_bf16(v1[2], v1[3]);
                    *(u32x4*)(rowp + bj * HALF) = w; } }
    }
};
struct EpiStoreBf16W {
    static constexpr int PERM = 3, NSTORE = 16; static constexpr bool MIDSTORE = true, ALLTRIPS = false;
    bf16* O; int ldc; int coff; float scale; int ntile;
    __device__ __forceinline__ void store(const f32x4 (&acc)[2][2][4][2], const Unit& u, int s, int wr, int wc, int fr, int fq) const {
        const int odd = fr & 1;
        int row0 = u.pm * BM + wr * 64 + fr; const int col0 = coff + (u.pn * ntile + s) * BM + wc * 64 + 8 * fq + 32 * odd;
        asm volatile("" : "+v"(row0));
#pragma unroll
        for (int ai = 0; ai < 2; ++ai)
#pragma unroll
            for (int m = 0; m < 4; ++m) {
                u32x4 w[2];
#pragma unroll
                for (int bj = 0; bj < 2; ++bj) { const f32x4 v0 = acc[ai][bj][m][0] * scale, v1 = acc[ai][bj][m][1] * scale;
                    w[bj].x = cvt_pk_bf16(v0[0], v0[1]); w[bj].y = cvt_pk_bf16(v0[2], v0[3]); w[bj].z = cvt_pk_bf16(v1[0], v1[1]); w[bj].w = cvt_pk_bf16(v1[2], v1[3]); }
                const u32x4 snd = odd ? w[0] : w[1]; u32x4 rcv;
#pragma unroll
                for (int q = 0; q < 4; ++q) rcv[q] = (unsigned)__builtin_amdgcn_update_dpp(0, (int)snd[q], 0xB1  , 0xF, 0xF, false);
                const u32x4 A = odd ? rcv : w[0], B = odd ? w[1] : rcv;
                bf16* base = O + (size_t)(row0 - odd + ai * HALF + m * 16) * ldc + col0;
                if (EPI_NT) { __builtin_nontemporal_store(A, (u32x4*)base); __builtin_nontemporal_store(B, (u32x4*)(base + ldc)); } else { *(u32x4*)base = A; *(u32x4*)(base + ldc) = B; } }
    }
    __device__ __forceinline__ void mid(f32x4 (&acc)[2][2][4][2], const Unit& u, int s, int wr, int wc, int fr, int fq) const {
        store(acc, u, s, wr, wc, fr, fq);
#pragma unroll
        for (int a = 0; a < 2; ++a)
#pragma unroll
            for (int b = 0; b < 2; ++b)
#pragma unroll
                for (int m = 0; m < 4; ++m)
#pragma unroll
                    for (int n = 0; n < 2; ++n) acc[a][b][m][n] = (f32x4){0.f, 0.f, 0.f, 0.f};
    }
    __device__ __forceinline__ void operator()(const f32x4 (&acc)[2][2][4][2], const Unit& u, int wr, int wc, int fr, int fq) const { store(acc, u, ntile - 1, wr, wc, fr, fq); }
};
template <bool ADD> struct EpiGate {
    static constexpr int PERM = 1, NSTORE = 16; const bf16* proj; int gcol; bf16* merged; float scale; unsigned char* m8;
    __device__ __forceinline__ void operator()(const f32x4 (&acc)[2][2][4][2], const Unit& u, int wr, int wc, int fr, int fq) const {
        const int row0 = u.pm * BM + wr * 64 + fr, col0 = u.pn * BM + wc * 32 + 8 * fq;
#pragma unroll
        for (int ai = 0; ai < 2; ++ai)
#pragma unroll
            for (int m = 0; m < 4; ++m) { const size_t row = (size_t)(row0 + ai * HALF + m * 16);
#pragma unroll
                for (int bj = 0; bj < 2; ++bj) { f32x4 v0 = acc[ai][bj][m][0] * scale, v1 = acc[ai][bj][m][1] * scale;
                    const u32x4 g = *(const u32x4*)(proj + row * PLD + gcol + col0 + bj * HALF);
                    v0[0] *= sigmoidf_(bflo(g.x)); v0[1] *= sigmoidf_(bfhi(g.x)); v0[2] *= sigmoidf_(bflo(g.y)); v0[3] *= sigmoidf_(bfhi(g.y));
                    v1[0] *= sigmoidf_(bflo(g.z)); v1[1] *= sigmoidf_(bfhi(g.z)); v1[2] *= sigmoidf_(bflo(g.w)); v1[3] *= sigmoidf_(bfhi(g.w));
                    bf16* mp = merged + row * DM + col0 + bj * HALF;
                    if (ADD) { const u32x4 o = *(const u32x4*)mp; v0[0] += bflo(o.x); v0[1] += bfhi(o.x); v0[2] += bflo(o.y); v0[3] += bfhi(o.y); v1[0] += bflo(o.z); v1[1] += bfhi(o.z); v1[2] += bflo(o.w); v1[3] += bfhi(o.w); }
                    if (ADD && F8O) { v0 = v0 * MRG8_SCALE; v1 = v1 * MRG8_SCALE; int t0 = 0, t1 = 0;
                        t0 = __builtin_amdgcn_cvt_pk_fp8_f32(v0[0], v0[1], t0, false); t0 = __builtin_amdgcn_cvt_pk_fp8_f32(v0[2], v0[3], t0, true);
                        t1 = __builtin_amdgcn_cvt_pk_fp8_f32(v1[0], v1[1], t1, false); t1 = __builtin_amdgcn_cvt_pk_fp8_f32(v1[2], v1[3], t1, true);
                        *(u32x2*)(m8 + row * DM + col0 + bj * HALF) = (u32x2){(unsigned)t0, (unsigned)t1}; }
                    else { u32x4 w; w.x = cvt_pk_bf16(v0[0], v0[1]); w.y = cvt_pk_bf16(v0[2], v0[3]); w.z = cvt_pk_bf16(v1[0], v1[1]); w.w = cvt_pk_bf16(v1[2], v1[3]);
                        *(u32x4*)mp = w; } } }
    }
};
struct EpiBranch {
    static constexpr int PERM = 1, NSTORE = 16; static constexpr bool MIDSTORE = false, ALLTRIPS = false; const bf16* proj; bf16* merged;
    __device__ __forceinline__ void mid(f32x4 (&acc)[2][2][4][2], const Unit& u, int, int wr, int wc, int fr, int fq) const {
        int row0 = u.pm * BM + wr * 64 + fr; const int col0 = u.pn * BM + wc * 32 + 8 * fq;
        asm volatile("" : "+v"(row0));
#pragma unroll
        for (int ai = 0; ai < 2; ++ai) {
            u32x4 ga[4][2], gb[4][2];
#pragma unroll
            for (int m = 0; m < 4; ++m)
#pragma unroll
                for (int bj = 0; bj < 2; ++bj) { const bf16* gp = proj + (size_t)(row0 + ai * HALF + m * 16) * PLD + col0 + bj * HALF; ga[m][bj] = *(const u32x4*)(gp + C_GA); gb[m][bj] = *(const u32x4*)(gp + C_GB); }
#pragma unroll
            for (int m = 0; m < 4; ++m)
#pragma unroll
                for (int bj = 0; bj < 2; ++bj)
#pragma unroll
                    for (int q = 0; q < 4; ++q) { const unsigned wa = ga[m][bj][q], wb = gb[m][bj][q];
                        const float r0 = (1.0f + ex2(-fmaxf(bflo(wb), -60.f) * LOG2E)) * __builtin_amdgcn_rcpf(1.0f + ex2(-bflo(wa) * LOG2E)), r1 = (1.0f + ex2(-fmaxf(bfhi(wb), -60.f) * LOG2E)) * __builtin_amdgcn_rcpf(1.0f + ex2(-bfhi(wa) * LOG2E));
                        acc[ai][bj][m][q >> 1][2 * (q & 1)] *= r0; acc[ai][bj][m][q >> 1][2 * (q & 1) + 1] *= r1; }
            asm volatile("" ::: "memory");
        }
    }
    __device__ __forceinline__ void operator()(const f32x4 (&acc)[2][2][4][2], const Unit& u, int wr, int wc, int fr, int fq) const {
        int row0 = u.pm * BM + wr * 64 + fr; const int col0 = u.pn * BM + wc * 32 + 8 * fq;
        asm volatile("" : "+v"(row0));
#pragma unroll
        for (int ai = 0; ai < 2; ++ai)
#pragma unroll
            for (int m = 0; m < 4; ++m) { const size_t row = (size_t)(row0 + ai * HALF + m * 16);
#pragma unroll
                for (int bj = 0; bj < 2; ++bj) { f32x4 v0 = acc[ai][bj][m][0], v1 = acc[ai][bj][m][1];
                    const u32x4 g = *(const u32x4*)(proj + row * PLD + C_GB + col0 + bj * HALF);
#define SGC(x) sigmoidf_(fmaxf((x), -60.f))
                    v0[0] *= SGC(bflo(g.x)); v0[1] *= SGC(bfhi(g.x)); v0[2] *= SGC(bflo(g.y)); v0[3] *= SGC(bfhi(g.y));
                    v1[0] *= SGC(bflo(g.z)); v1[1] *= SGC(bfhi(g.z)); v1[2] *= SGC(bflo(g.w)); v1[3] *= SGC(bfhi(g.w));
#undef SGC
                    u32x4 w; w.x = cvt_pk_bf16(v0[0], v0[1]); w.y = cvt_pk_bf16(v0[2], v0[3]); w.z = cvt_pk_bf16(v1[0], v1[1]); w.w = cvt_pk_bf16(v1[2], v1[3]);
                    *(u32x4*)(merged + row * DM + col0 + bj * HALF) = w; } }
    }
};
struct EpiF32 {
    static constexpr int PERM = 0, NSTORE = 32; float* C; int ldc;
    __device__ __forceinline__ void operator()(const f32x4 (&acc)[2][2][4][2], const Unit& u, int wr, int wc, int fr, int fq) const {
        const int row0 = u.pm * BM + wr * 64 + fr, col0 = u.pn * BM + wc * 32 + 4 * fq;
#pragma unroll
        for (int ai = 0; ai < 2; ++ai)
#pragma unroll
            for (int m = 0; m < 4; ++m) { float* rowp = C + (size_t)(row0 + ai * HALF + m * 16) * ldc + col0;
#pragma unroll
                for (int bj = 0; bj < 2; ++bj)
#pragma unroll
                    for (int n = 0; n < 2; ++n) *(f32x4*)(rowp + bj * HALF + n * 16) = acc[ai][bj][m][n]; }
    }
};
template <int STAGE> struct MoeSched {
    static constexpr bool GATHER = (STAGE == 1); static constexpr int META = STAGE;
    static constexpr bool F8 = (STAGE == 1) ? (bool)MOE1_FP8 : (bool)MOE2_FP8;
    static constexpr bool PAIR = (STAGE == 2) && MOE2_PAIR;
    static constexpr int NPN = (STAGE == 1) ? 2 : (PAIR ? 2 : 4), K = (STAGE == 1) ? (F8 ? 512 : 1024) : (F8 ? 128 : 256);
    const int* tile_e; const int* tokp; const int* ypos; const float* wpad; const char* Abase; const char* Bbase; int nrt, nU, G, c;
    __device__ __forceinline__ void meta_issue(const Unit& u, LAS unsigned char* slot, int wid, int lane_) const {
        int lane; asm volatile("v_mbcnt_lo_u32_b32 %0, -1, 0\n\tv_mbcnt_hi_u32_b32 %0, -1, %0" : "=v"(lane));
        if (STAGE == 1) { if (wid == 0) __builtin_amdgcn_global_load_lds((const unsigned*)(tokp + u.pm * BM + 4 * lane), (LAS unsigned*)slot, 16, 0, 0); }
        else { if (wid == 0) __builtin_amdgcn_global_load_lds((const unsigned*)(ypos + u.pm * BM + 4 * lane), (LAS unsigned*)slot, 16, 0, 0);
               if (wid == 1) __builtin_amdgcn_global_load_lds((const unsigned*)(wpad + u.pm * BM + 4 * lane), (LAS unsigned*)(slot + 1024), 16, 0, 0); }
    }
    __device__ __forceinline__ unsigned meta_off(const LAS unsigned char* slot, int row) const { int tk = ((const LAS int*)slot)[row]; tk = tk < 0 ? 0 : tk; return (unsigned)tk * (unsigned)(K * 2); }
    __device__ __forceinline__ bool next(int i, Unit& u) const {
        const long L = (long)i * G + c; if (L >= nU) return false;
        int id = (int)L; { const int q = nU / NXCD, r = nU % NXCD, xcd = id % NXCD, off = id / NXCD; id = (xcd < r ? xcd * (q + 1) : r * (q + 1) + (xcd - r) * q) + off; }
        const int tq = id / NPN; u.pn = id % NPN; u.pm = tq < nrt ? tq : SH_TILE0 + (tq - nrt); { int ev; const int* tp = tile_e + u.pm; asm volatile("s_load_dword %0, %1, 0x0\n\ts_waitcnt lgkmcnt(0)" : "=s"(ev) : "s"(tp) : "memory"); u.e = ev; } return true;
    }
    __device__ __forceinline__ const char* a_ptr(const Unit& u) const { return STAGE == 1 ? Abase : Abase + (size_t)u.pm * BM * K * 2; }
    __device__ __forceinline__ const char* b_ptr(const Unit& u) const { return Bbase + ((size_t)u.e * ((PAIR ? 4 : NPN) * BM) + (size_t)u.pn * (PAIR ? 2 : 1) * BM) * K * 2; }
    __device__ __forceinline__ const char* a_seg(const Unit& u, int) const { return a_ptr(u); }
    __device__ __forceinline__ const char* b_seg(const Unit& u, int s) const { return b_ptr(u) + (size_t)s * BM * K * 2; }
    __device__ __forceinline__ unsigned a_off(const Unit& u, int row) const {
        if (STAGE == 1) { int tk = tokp[u.pm * BM + row]; tk = tk < 0 ? 0 : tk; return (unsigned)tk * (unsigned)(K * 2); }
        return (unsigned)(row * K) * 2u;
    }
};
struct EpiHid {
    static constexpr int PERM = 1, NSTORE = 8; static constexpr float unscale = MOE1_FP8 ? 1.0f / W8_SCALE : 1.0f; bf16* hid;
    __device__ __forceinline__ void operator()(const f32x4 (&acc)[2][2][4][2], const Unit& u, int wr, int wc, int fr, int fq) const {
        const int row0 = u.pm * BM + wr * 64 + fr, col0 = u.pn * HALF + wc * 32 + 8 * fq;
#pragma unroll
        for (int ai = 0; ai < 2; ++ai)
#pragma unroll
            for (int m = 0; m < 4; ++m) { float hv[8];
#pragma unroll
                for (int n = 0; n < 2; ++n)
#pragma unroll
                    for (int q = 0; q < 4; ++q) { const float gt = acc[ai][0][m][n][q] * unscale, up = acc[ai][1][m][n][q] * unscale; hv[4 * n + q] = gt * sigmoidf_(gt) * up; }
                if (MOE2_FP8) { int t0 = 0, t1 = 0;
                    t0 = __builtin_amdgcn_cvt_pk_fp8_f32(clamp8(hv[0] * HID8_SCALE), clamp8(hv[1] * HID8_SCALE), t0, false); t0 = __builtin_amdgcn_cvt_pk_fp8_f32(clamp8(hv[2] * HID8_SCALE), clamp8(hv[3] * HID8_SCALE), t0, true);
                    t1 = __builtin_amdgcn_cvt_pk_fp8_f32(clamp8(hv[4] * HID8_SCALE), clamp8(hv[5] * HID8_SCALE), t1, false); t1 = __builtin_amdgcn_cvt_pk_fp8_f32(clamp8(hv[6] * HID8_SCALE), clamp8(hv[7] * HID8_SCALE), t1, true);
                    *(u32x2*)((unsigned char*)hid + (size_t)(row0 + ai * HALF + m * 16) * EDIM + col0) = (u32x2){(unsigned)t0, (unsigned)t1}; }
                else { u32x4 w; w.x = cvt_pk_bf16(hv[0], hv[1]); w.y = cvt_pk_bf16(hv[2], hv[3]); w.z = cvt_pk_bf16(hv[4], hv[5]); w.w = cvt_pk_bf16(hv[6], hv[7]);
                    *(u32x4*)(hid + (size_t)(row0 + ai * HALF + m * 16) * EDIM + col0) = w; } }
    }
};
struct EpiY {
    static constexpr int PERM = 2, NSTORE = 8; static constexpr bool MIDSTORE = true, ALLTRIPS = (bool)MOE2_PAIR; unsigned char* Y; int var;
    __device__ __forceinline__ void dummy(int lane) const {
        const unsigned char* q = Y + (size_t)(NASSIGN + T) * DM; const unsigned o = (unsigned)lane * 16u; const u32x4 z = (u32x4){0u, 0u, 0u, 0u};
#pragma unroll
        for (int i = 0; i < NSTORE; ++i) asm volatile("global_store_dwordx4 %0, %1, %2" :: "v"(o), "v"(z), "s"(q) : "memory");
    }
    __device__ __forceinline__ void store(const f32x4 (&acc)[2][2][4][2], const Unit& u, int pn, int wr, int wc, int fr, int fq) const {
        const int col0 = pn * BM + wc * 64 + 16 * fq;
#pragma unroll
        for (int ai = 0; ai < 2; ++ai)
#pragma unroll
            for (int m = 0; m < 4; ++m) { const int rl = wr * 64 + fr + ai * HALF + m * 16;
                const int yp = ((const LAS int*)u.meta)[rl]; const float wv = ((const LAS float*)(u.meta + 1024))[rl] * (MOE2_FP8 ? Y8_SCALE / (W8_SCALE * HID8_SCALE) : Y8_SCALE);
                size_t yrow = yp >= 0 ? (size_t)yp : (size_t)(NASSIGN + T); u32x4 w;
                if (PROBE_MOE2 && var == 2) yrow &= 4095;
#pragma unroll
                for (int bj = 0; bj < 2; ++bj)
#pragma unroll
                    for (int n = 0; n < 2; ++n) { const f32x4 v = acc[ai][bj][m][n] * wv; int t = 0;
                        t = __builtin_amdgcn_cvt_pk_fp8_f32(clamp8(v[0]), clamp8(v[1]), t, false); t = __builtin_amdgcn_cvt_pk_fp8_f32(clamp8(v[2]), clamp8(v[3]), t, true); w[2 * bj + n] = (unsigned)t; }
                if (!(PROBE_MOE2 && var == 3)) *(u32x4*)(Y + yrow * DM + col0) = w; }
    }
    __device__ __forceinline__ void mid(f32x4 (&acc)[2][2][4][2], const Unit& u, int, int wr, int wc, int fr, int fq) const {
        store(acc, u, 2 * u.pn, wr, wc, fr, fq);
#pragma unroll
        for (int a = 0; a < 2; ++a)
#pragma unroll
            for (int b = 0; b < 2; ++b)
#pragma unroll
                for (int m = 0; m < 4; ++m)
#pragma unroll
                    for (int n = 0; n < 2; ++n) acc[a][b][m][n] = (f32x4){0.f, 0.f, 0.f, 0.f};
    }
    __device__ __forceinline__ void operator()(const f32x4 (&acc)[2][2][4][2], const Unit& u, int wr, int wc, int fr, int fq) const {
        store(acc, u, MOE2_PAIR ? 2 * u.pn + 1 : u.pn, wr, wc, fr, fq);
    }
};
}

__device__ __forceinline__ void cvt_p2(const Ctx& F) {
    constexpr int SPLIT = CVT_GB + P2_CVT_HI * 1024;
    if (F.G == 256) { if (F.blk >= 128) cvt_experts_from<true>(F, F.lds + F.wave * 8448, CVT_GB + (F.blk - 128) * NWAVES + F.wave, 1024, SPLIT);
                      else cvt_experts_from<true>(F, F.lds + F.wave * 8448, SPLIT + F.blk * NWAVES + F.wave, 1024, CVT_G1); }
    else cvt_experts<true>(F, F.lds + F.wave * 8448, CVT_GB, CVT_G1);
}
template <int MODE> __device__ __forceinline__ void phase_dense_fast(const Ctx& F) {
    pg8::DenseSched S; constexpr bool F8 = (MODE == 1 || MODE == 2) ? (bool)F8B : (MODE == 3) ? (bool)F8O : false;
    if (MODE == 0) {
        const int grp = (F.blk >> 3) & 7;
        if (INPROJ_LATE_US > 0 && F.G == 256 && F.blk >= 128) {
            const unsigned long long t0 = __builtin_amdgcn_s_memrealtime(); while (__builtin_amdgcn_s_memrealtime() - t0 < (unsigned long long)(INPROJ_LATE_US * 100)) __builtin_amdgcn_s_sleep(8); }
        pg8::EpiStoreBf16W E{(bf16*)(F.ws + WS_PROJ), PLD, 0, 1.0f, 1};
        if (INPROJ_QUAD && !F8G) {
            const bool spreadq = NEW_CVT && !CVT_IN_P0; const int g4 = grp & 3;
            pg8::DenseSched Sq; Sq.init(F.ws + WS_A1, F.ws + WS_WIN, T, 4 * 256, 1024, F.G, F.blk); Sq.nseg = 4;
            pg8::EpiStoreBf16W Eq{(bf16*)(F.ws + WS_PROJ), PLD, 0, 1.0f, 4};
            int Kq = 4096; asm volatile("" : "+s"(Kq));
            if (spreadq && g4 == 0) { cvt_p2(F); __syncthreads(); }
            Sq.i_lo = 0; Sq.i_hi = (spreadq && g4 == 1) ? 1 : (1 << 30); pg8::gemm_phase<pg8::EpiStoreBf16W, pg8::DenseSched, true, false, 4>(F.lds, Kq, Sq, Eq);
            if (spreadq && g4 == 1) { cvt_p2(F); __syncthreads(); Sq.i_lo = 1; Sq.i_hi = 1 << 30; pg8::gemm_phase<pg8::EpiStoreBf16W, pg8::DenseSched, true, false, 4>(F.lds, Kq, Sq, Eq); }
            if (spreadq && g4 == 2) { cvt_p2(F); __syncthreads(); }
            pg8::DenseSched Ss; Ss.init(F.ws + WS_A1, F.ws + WS_WIN + (size_t)16 * 256 * 1024 * 2, T, 256, 1024, F.G, F.blk);
            pg8::EpiStoreBf16W Es{(bf16*)(F.ws + WS_PROJ), PLD, 16 * 256, 1.0f, 1};
            pg8::gemm_phase<pg8::EpiStoreBf16W, pg8::DenseSched, true>(F.lds, 1024, Ss, Es);
            if (spreadq && g4 == 3) { cvt_p2(F); __syncthreads(); }
            return;
        }
        S.init(F.ws + WS_A1, F.ws + WS_WIN, T, F8G ? C_GA : INW, 1024, F.G, F.blk);
        const bool spread = NEW_CVT && !CVT_IN_P0;
        const int split = !spread ? 0 : F8G ? (grp < 2 ? 0 : grp < 4 ? 2 : 1 << 30) : grp;
        S.i_lo = 0; S.i_hi = split; pg8::gemm_phase<pg8::EpiStoreBf16W, pg8::DenseSched, true>(F.lds, 1024, S, E);
        if (spread && (!F8G || grp < 4)) { cvt_p2(F); __syncthreads(); }
        S.i_lo = split; S.i_hi = 1 << 30; pg8::gemm_phase<pg8::EpiStoreBf16W, pg8::DenseSched, true>(F.lds, 1024, S, E);
        if (F8G) {
            pg8::DenseSched S8; S8.init(F.ws + WS_A3, F.ws + WS_WIN8, T, INW - C_GA, 512, F.G, F.blk);
            pg8::EpiStoreBf16 E8{(bf16*)(F.ws + WS_PROJ), PLD, C_GA, 1.0f / W8_SCALE};
            const int split8 = !spread ? 0 : (grp < 6 ? 0 : 2);
            if (spread && grp >= 4 && grp < 6) { cvt_p2(F); __syncthreads(); }
            S8.i_lo = 0; S8.i_hi = split8; pg8::gemm_phase<pg8::EpiStoreBf16, pg8::DenseSched, true, true>(F.lds, 512, S8, E8);
            if (spread && grp >= 6) { cvt_p2(F); __syncthreads(); }
            S8.i_lo = split8; S8.i_hi = 1 << 30; pg8::gemm_phase<pg8::EpiStoreBf16, pg8::DenseSched, true, true>(F.lds, 512, S8, E8);
        }
    }
    else if (MODE == 1 && FUSE_BR) {
        S.init(F.ws + WS_A2, F.ws + WS_WA, T, DM, 512, F.G, F.blk); S.A2 = (const char*)(F.ws + WS_A2 + (size_t)T * 1024); S.Bt2 = (const char*)(F.ws + WS_WB);
        pg8::EpiBranch E{(const bf16*)(F.ws + WS_PROJ), (bf16*)(F.ws + WS_A3)};
        int Kk = 1024; asm volatile("" : "+s"(Kk));
        pg8::gemm_phase<pg8::EpiBranch, pg8::DenseSched, true, false, 2>(F.lds, Kk, S, E); }
    else if (MODE == 2 && FUSE_BR) { }
    else if (MODE == 1) { S.init(F.ws + WS_A2, F.ws + WS_WA, T, DM, F8 ? 256 : 512, F.G, F.blk); pg8::EpiGate<false> E{(const bf16*)(F.ws + WS_PROJ), C_GA, (bf16*)(F.ws + WS_A3), F8 ? 1.0f / (W8_SCALE * ATT8_SCALE) : 1.0f, nullptr};
        pg8::gemm_phase<pg8::EpiGate<false>, pg8::DenseSched, true, F8>(F.lds, F8 ? 256 : 512, S, E); }
    else if (MODE == 2) { S.init(F.ws + WS_A2 + (size_t)T * (F8 ? 512 : 1024), F.ws + WS_WB, T, DM, F8 ? 256 : 512, F.G, F.blk);
        pg8::EpiGate<true> E{(const bf16*)(F.ws + WS_PROJ), C_GB, (bf16*)(F.ws + WS_A3), F8 ? 1.0f / (W8_SCALE * ATT8_SCALE) : 1.0f, (unsigned char*)(F.ws + WS_A1)};
        pg8::gemm_phase<pg8::EpiGate<true>, pg8::DenseSched, true, F8>(F.lds, F8 ? 256 : 512, S, E); }
    else if (MODE == 3) { S.init(F.ws + (F8 ? WS_A1 : WS_A3), F.ws + WS_WOUT, T, DM, F8 ? 512 : 1024, F.G, F.blk);
        pg8::EpiStoreBf16 E{(bf16*)(F.ws + (F8 ? WS_A3 : WS_A1)), DM, 0, F8 ? 1.0f / (W8_SCALE * MRG8_SCALE) : 1.0f};
        pg8::gemm_phase<pg8::EpiStoreBf16, pg8::DenseSched, true, F8>(F.lds, F8 ? 512 : 1024, S, E); }
    else { S.init(F.ws + WS_A2, F.ws + WS_WR, T, NE, 1024, F.G, F.blk); pg8::EpiF32 E{(float*)(F.ws + WS_A1), NE}; pg8::gemm_phase<pg8::EpiF32, pg8::DenseSched, true>(F.lds, 1024, S, E); }
}
template <int STAGE> __device__ __forceinline__ void phase_moe_fast(const Ctx& F) {
    const int nrt = (int)__hip_atomic_load((unsigned*)(F.ws + WS_CTL) + CW_NRT, __ATOMIC_RELAXED, __HIP_MEMORY_SCOPE_AGENT);
    pg8::MoeSched<STAGE> S;
    S.tile_e = (const int*)(F.ws + WS_TILEE); S.tokp = (const int*)(F.ws + WS_TOKP); S.ypos = (const int*)(F.ws + WS_YPOS); S.wpad = (const float*)(F.ws + WS_WPAD); S.nrt = nrt; S.nU = (nrt + T / 256) * pg8::MoeSched<STAGE>::NPN; S.G = F.G; S.c = F.blk;
    if (STAGE == 1) { S.Abase = (const char*)(F.ws + (MOE1_FP8 ? WS_H2F8 : WS_A2)); S.Bbase = (const char*)(F.ws + WS_WGU); pg8::EpiHid E{(bf16*)(F.ws + WS_A3)};
        pg8::gemm_phase<pg8::EpiHid, pg8::MoeSched<STAGE>, true, pg8::MoeSched<STAGE>::F8>(F.lds, pg8::MoeSched<STAGE>::K, S, E); }
    else { S.Abase = (const char*)(F.ws + WS_A3); S.Bbase = (const char*)(F.ws + WS_WD); pg8::EpiY E{(unsigned char*)(F.ws + WS_Y), PROBE_MOE2 ? F.karg_int(50) : 0};
        int Kk = pg8::MoeSched<STAGE>::K * (MOE2_PAIR ? 2 : 1); asm volatile("" : "+s"(Kk));
        pg8::gemm_phase<pg8::EpiY, pg8::MoeSched<STAGE>, false, pg8::MoeSched<STAGE>::F8, MOE2_PAIR ? 2 : 1>(F.lds, Kk, S, E); }
}

__device__ __forceinline__ unsigned cvtpk(float lo, float hi) { unsigned r; asm volatile("v_cvt_pk_bf16_f32 %0, %1, %2" : "=v"(r) : "v"(lo), "v"(hi)); return r; }
__device__ __forceinline__ void store_o_tile(const f32x16 (&o)[2], bf16* dst, LAS unsigned char* stg, int lane) {
    const int r32 = lane & 31, hi = lane >> 5;
    if (F8B) {
#pragma unroll
        for (int dt = 0; dt < 2; ++dt)
#pragma unroll
            for (int r = 0; r < 16; ++r) { const int t = __builtin_amdgcn_cvt_pk_fp8_f32(o[dt][r] * ATT8_SCALE, 0.f, 0, false); *(LAS unsigned char*)(stg + crow(r, hi) * 64 + 32 * dt + r32) = (unsigned char)t; }
        LDS_WAIT(); asm volatile("" ::: "memory");
#pragma unroll
        for (int i = 0; i < 2; ++i) { const int row = i * 16 + (lane >> 2), ch = lane & 3; *(u32x4*)((unsigned char*)dst + (size_t)row * 512 + ch * 16) = *(const LAS u32x4*)(stg + row * 64 + ch * 16); }
        LDS_WAIT(); asm volatile("" ::: "memory");
        return;
    }
#pragma unroll
    for (int dt = 0; dt < 2; ++dt)
#pragma unroll
        for (int r = 0; r < 16; ++r) *(LAS unsigned short*)(stg + crow(r, hi) * 128 + (32 * dt + r32) * 2) = (unsigned short)f2bf(o[dt][r]);
    LDS_WAIT(); asm volatile("" ::: "memory");
#pragma unroll
    for (int i = 0; i < 4; ++i) { const int row = i * 8 + (lane >> 3), ch = lane & 7; *(u32x4*)(dst + (size_t)row * 512 + ch * 8) = *(const LAS u32x4*)(stg + row * 128 + ch * 16); }
    LDS_WAIT(); asm volatile("" ::: "memory");
}
__device__ __forceinline__ void phase_swa(const Ctx& F) { const float* const p_sinks = F.in(7); const float* const p_relb = F.in(8);
    const bf16* proj = (const bf16*)(F.ws + WS_PROJ);
    bf16* ya = (bf16*)(F.ws + WS_A2);
    LAS unsigned char* Kl = F.lds;
    LAS unsigned char* Vl = F.lds + 24576;
    LAS float* biasL = (LAS float*)(F.lds + 49152);
    LAS unsigned char* stg = F.lds + 65536 + F.wave * 4096;
    const int r32 = F.lane & 31, hi = F.lane >> 5;
    __syncthreads();
    for (int i = F.tid; i < 8 * 384; i += NTHR) { const int hd = i / 384, ri = i % 384; biasL[i] = p_relb[(int)T5B[ri] * 8 + hd] * LOG2E; }
    constexpr int NU = NB * 32 * 2;
    const int g = F.wave >> 1, qh = F.wave & 1;
    const int skey = F.tid >> 3, sch = F.tid & 7;
    u32x4 kreg[3], vreg[3]; u32x4 qn[4];
#define SWA_DECODE(uu, hk_, c_, b_, nkc_, kstart_) const int hk_ = (uu) & 1, c_ = ((uu) >> 1) & 31, b_ = (uu) >> 6; const int nkc_ = (c_ < 2 ? c_ : 2) + 1, kstart_ = (c_ - nkc_ + 1) * 64
#define SWA_REQUEST(uu) do { SWA_DECODE(uu, hk_, c_, b_, nkc_, ks_); \
        _Pragma("unroll") for (int i = 0; i < 3; ++i) { const int key = skey + 64 * i; const int keyc = key < nkc_ * 64 ? key : 0; const bf16* s_ = proj + (size_t)(b_ * SEQ + ks_ + keyc) * PLD + hk_ * 64 + sch * 8; \
            kreg[i] = *(const u32x4*)(s_ + C_KA); vreg[i] = *(const u32x4*)(s_ + C_VA); } \
        _Pragma("unroll") for (int d0 = 0; d0 < 4; ++d0) qn[d0] = *(const u32x4*)(proj + (size_t)(b_ * SEQ + c_ * 64 + qh * 32 + r32) * PLD + C_QA + (hk_ * 4 + g) * 64 + d0 * 16 + hi * 8); } while (0)
    int u = (ATT_XCD && (F.G & 7) == 0) ? (F.blk & 7) * (F.G >> 3) + (F.blk >> 3) : F.blk;
    if (u < NU) SWA_REQUEST(u);
    for (; u < NU; u += F.G) {
        SWA_DECODE(u, hk, c, b, nkc, kstart); const int nk = nkc * 64, nkt = nkc * 2;
        __syncthreads();
#pragma unroll
        for (int i = 0; i < 3; ++i) { const int key = skey + 64 * i;
            if (key < nk) { *(LAS u32x4*)(Kl + sch * 3072 + key * 16) = kreg[i]; *(LAS u32x4*)(Vl + (sch >> 2) * 12288 + key * 64 + (sch & 3) * 16) = vreg[i]; } }
        bf16x8 qf[4];
#pragma unroll
        for (int d0 = 0; d0 < 4; ++d0) { const float sc = 0.125f * LOG2E; u32x4 qs; const u32x4 qv = qn[d0];
            qs.x = cvtpk(bflo(qv.x) * sc, bfhi(qv.x) * sc); qs.y = cvtpk(bflo(qv.y) * sc, bfhi(qv.y) * sc); qs.z = cvtpk(bflo(qv.z) * sc, bfhi(qv.z) * sc); qs.w = cvtpk(bflo(qv.w) * sc, bfhi(qv.w) * sc);
            qf[d0] = __builtin_bit_cast(bf16x8, qs); }
        __syncthreads();
        { const int un = (u + F.G < NU) ? u + F.G : u; SWA_REQUEST(un); }
        const int head = hk * 4 + g, qpos = c * 64 + qh * 32 + r32;
        f32x16 sc[6];
#pragma unroll
        for (int kt = 0; kt < 6; ++kt) {
            sc[kt] = (f32x16){0.f, 0.f, 0.f, 0.f, 0.f, 0.f, 0.f, 0.f, 0.f, 0.f, 0.f, 0.f, 0.f, 0.f, 0.f, 0.f};
            if (kt < nkt) {
#pragma unroll
                for (int d0 = 0; d0 < 4; ++d0) { const bf16x8 kf = *(const LAS bf16x8*)(Kl + (2 * d0 + hi) * 3072 + (32 * kt + r32) * 16);
                    sc[kt] = __builtin_amdgcn_mfma_f32_32x32x16_bf16(kf, qf[d0], sc[kt], 0, 0, 0); }
            }
        }
        const float sink2 = p_sinks[head] * LOG2E;
        float m = sink2;
        const LAS float* bl = biasL + head * 384 + 255 + (kstart - qpos);
#pragma unroll
        for (int kt = 0; kt < 6; ++kt) if (kt < nkt) {
#pragma unroll
            for (int r = 0; r < 16; ++r) { const float l2 = sc[kt][r] + bl[32 * kt + crow(r, hi)]; sc[kt][r] = l2; m = fmaxf(m, l2); }
        }
        m = fmaxf(m, __shfl_xor(m, 32));
        float sum = 0.f;
#pragma unroll
        for (int kt = 0; kt < 6; ++kt) if (kt < nkt) {
#pragma unroll
            for (int r = 0; r < 16; ++r) { const float p = ex2(sc[kt][r] - m); sc[kt][r] = p; sum += p; }
        }
        sum += __shfl_xor(sum, 32);
        const float inv = 1.0f / (sum + ex2(sink2 - m));
        f32x16 o[2];
        o[0] = (f32x16){0.f, 0.f, 0.f, 0.f, 0.f, 0.f, 0.f, 0.f, 0.f, 0.f, 0.f, 0.f, 0.f, 0.f, 0.f, 0.f}; o[1] = o[0];
        const int vlane = ((F.lane >> 4) & 1) * 32 + (F.lane & 3) * 8 + (4 * hi + ((F.lane & 15) >> 2)) * 64;
#pragma unroll
        for (int kt = 0; kt < 6; ++kt) if (kt < nkt) {
#pragma unroll
            for (int ks = 0; ks < 2; ++ks) {
                u32x4 pw; pw.x = cvtpk(sc[kt][8 * ks] * inv, sc[kt][8 * ks + 1] * inv); pw.y = cvtpk(sc[kt][8 * ks + 2] * inv, sc[kt][8 * ks + 3] * inv);
                pw.z = cvtpk(sc[kt][8 * ks + 4] * inv, sc[kt][8 * ks + 5] * inv); pw.w = cvtpk(sc[kt][8 * ks + 6] * inv, sc[kt][8 * ks + 7] * inv);
                const bf16x8 pa = __builtin_bit_cast(bf16x8, pw);
#pragma unroll
                for (int dt = 0; dt < 2; ++dt) {
                    const LAS unsigned char* vp = Vl + dt * 12288 + (32 * kt + 16 * ks) * 64 + vlane;
                    const s16x4 lo = vtr(vp), hh = vtr(vp + 512);
                    const bf16x8 vf = (bf16x8){lo[0], lo[1], lo[2], lo[3], hh[0], hh[1], hh[2], hh[3]};
                    o[dt] = __builtin_amdgcn_mfma_f32_32x32x16_bf16(pa, vf, o[dt], 0, 0, 0);
                }
            }
        }
        if (F8B) store_o_tile(o, (bf16*)((unsigned char*)ya + (size_t)(b * SEQ + c * 64 + qh * 32) * 512 + head * 64), stg, F.lane);
        else store_o_tile(o, ya + (size_t)(b * SEQ + c * 64 + qh * 32) * 512 + head * 64, stg, F.lane);
    }
#undef SWA_DECODE
#undef SWA_REQUEST
}

__device__ __forceinline__ void phase_sb(const Ctx& F) {
    const bf16* proj = (const bf16*)(F.ws + WS_PROJ);
    bf16* yb = (bf16*)(F.ws + WS_A2) + (size_t)T * 512;
    volatile LAS int* flags = (volatile LAS int*)(F.lds + 131072);
    const int r32 = F.lane & 31, hi = F.lane >> 5;
    const int vlane = ((F.lane >> 4) & 1) * 32 + (F.lane & 3) * 8 + (4 * hi + ((F.lane & 15) >> 2)) * 64;
    const int skey = F.tid >> 3, sch = F.tid & 7;
    const unsigned kw = sch * 1024 + skey * 16, vw = 8192 + (sch >> 2) * 4096 + skey * 64 + (sch & 3) * 16;
    const int wh = F.wave >> 1, wq = F.wave & 1;
    for (int u = (ATT_XCD && (F.G & 7) == 0) ? (F.blk & 7) * (F.G >> 3) + (F.blk >> 3) : F.blk; u < NB * 2 * 32; u += F.G) {
        const int qb = (u + (u >> 5)) & 31, hg = (u >> 5) & 1, b = u >> 6;
        const int q0 = qb * 64, qw = q0 + wq * 32, qpos = qw + r32, head = hg * 4 + wh;
        const bf16* kvsrc = proj + (size_t)(b * SEQ + skey) * PLD + hg * 256 + sch * 8;
        const int kt0 = qb;
        __syncthreads();
        u32x4 kreg[4], vreg[4];
#pragma unroll
        for (int i = 0; i < 4; ++i) { kreg[i] = *(const u32x4*)(kvsrc + (size_t)kt0 * 64 * PLD + C_KB + i * 64); vreg[i] = *(const u32x4*)(kvsrc + (size_t)kt0 * 64 * PLD + C_VB + i * 64); }
        bf16x8 qf[4];
#pragma unroll
        for (int d0 = 0; d0 < 4; ++d0) {
            const u32x4 qv = *(const u32x4*)(proj + (size_t)(b * SEQ + qpos) * PLD + C_QB + head * 64 + d0 * 16 + hi * 8); u32x4 qs; const float sc = 0.125f * LOG2E;
            qs.x = cvtpk(bflo(qv.x) * sc, bfhi(qv.x) * sc); qs.y = cvtpk(bflo(qv.y) * sc, bfhi(qv.y) * sc); qs.z = cvtpk(bflo(qv.z) * sc, bfhi(qv.z) * sc); qs.w = cvtpk(bflo(qv.w) * sc, bfhi(qv.w) * sc);
            qf[d0] = __builtin_bit_cast(bf16x8, qs); }
#pragma unroll
        for (int i = 0; i < 4; ++i) { *(LAS u32x4*)(F.lds + i * 16384 + kw) = kreg[i]; *(LAS u32x4*)(F.lds + i * 16384 + vw) = vreg[i]; }
        if (kt0 >= 1) {
#pragma unroll
            for (int i = 0; i < 4; ++i) { kreg[i] = *(const u32x4*)(kvsrc + (size_t)(kt0 - 1) * 64 * PLD + C_KB + i * 64); vreg[i] = *(const u32x4*)(kvsrc + (size_t)(kt0 - 1) * 64 * PLD + C_VB + i * 64); } }
        f32x16 o[2];
        o[0] = (f32x16){0.f, 0.f, 0.f, 0.f, 0.f, 0.f, 0.f, 0.f, 0.f, 0.f, 0.f, 0.f, 0.f, 0.f, 0.f, 0.f}; o[1] = o[0];
        float R = 1.f; bool mydone = false;
        __syncthreads();
        for (int kt = kt0, it = 0; kt >= 0; --kt, ++it) {
            const int kb = kt * 64;
            LAS unsigned char* Kl = F.lds + (it & 1) * 65536 + wh * 16384; LAS unsigned char* Vl = Kl + 8192;
            if (!mydone) {
                f32x16 p0 = (f32x16){0.f, 0.f, 0.f, 0.f, 0.f, 0.f, 0.f, 0.f, 0.f, 0.f, 0.f, 0.f, 0.f, 0.f, 0.f, 0.f}, p1 = p0;
#pragma unroll
                for (int d0 = 0; d0 < 4; ++d0) {
                    const bf16x8 k0f = *(const LAS bf16x8*)(Kl + (2 * d0 + hi) * 1024 + r32 * 16), k1f = *(const LAS bf16x8*)(Kl + (2 * d0 + hi) * 1024 + (32 + r32) * 16);
                    p0 = __builtin_amdgcn_mfma_f32_32x32x16_bf16(k0f, qf[d0], p0, 0, 0, 0);
                    p1 = __builtin_amdgcn_mfma_f32_32x32x16_bf16(k1f, qf[d0], p1, 0, 0, 0);
                }
                float kp[32], lb[32];
                const bool diag = (kt == kt0);
#pragma unroll
                for (int e = 0; e < 32; ++e) {
                    const float z2 = (e < 16 ? p0[e] : p1[e - 16]);
                    const float uu = ex2(-fabsf(z2)), rr_ = __builtin_amdgcn_rcpf(1.0f + uu), ur = uu * rr_;
                    const bool pos = z2 >= 0.f;
                    lb[e] = pos ? rr_ : ur; kp[e] = pos ? ur : rr_;
                }
                if (diag) {
#pragma unroll
                    for (int e = 0; e < 32; ++e) { const bool valid = (kb + 8 * (e >> 2) + 4 * hi + (e & 3)) < qpos; kp[e] = valid ? kp[e] : 1.f; lb[e] = valid ? lb[e] : 0.f; }
                }
                float A = R;
#pragma unroll
                for (int i = 7; i >= 0; --i) {
                    const float gs = (kp[4 * i] * kp[4 * i + 1]) * (kp[4 * i + 2] * kp[4 * i + 3]);
                    const auto rr = __builtin_amdgcn_permlane32_swap(__float_as_uint(gs), __float_as_uint(gs), false, false);
                    const float g0 = __uint_as_float(rr[0]), g1 = __uint_as_float(rr[1]);
                    const float c3 = A * (hi == 0 ? g1 : 1.f), c2 = c3 * kp[4 * i + 3], c1 = c2 * kp[4 * i + 2], c0 = c1 * kp[4 * i + 1];
                    lb[4 * i + 3] *= c3; lb[4 * i + 2] *= c2; lb[4 * i + 1] *= c1; lb[4 * i] *= c0;
                    A *= g0 * g1;
                }
                R = A;
#pragma unroll
                for (int k4 = 0; k4 < 4; ++k4) {
                    u32x4 pw; pw.x = cvtpk(lb[8 * k4], lb[8 * k4 + 1]); pw.y = cvtpk(lb[8 * k4 + 2], lb[8 * k4 + 3]); pw.z = cvtpk(lb[8 * k4 + 4], lb[8 * k4 + 5]); pw.w = cvtpk(lb[8 * k4 + 6], lb[8 * k4 + 7]);
                    const bf16x8 pa = __builtin_bit_cast(bf16x8, pw);
#pragma unroll
                    for (int dt = 0; dt < 2; ++dt) {
                        const LAS unsigned char* vp = Vl + dt * 4096 + (16 * k4) * 64 + vlane;
                        const s16x4 lo = vtr(vp), hh = vtr(vp + 512);
                        const bf16x8 vf = (bf16x8){lo[0], lo[1], lo[2], lo[3], hh[0], hh[1], hh[2], hh[3]};
                        o[dt] = __builtin_amdgcn_mfma_f32_32x32x16_bf16(pa, vf, o[dt], 0, 0, 0);
                    }
                }
                mydone = __all(R < 3.5e-15f);
            }
            if (kt >= 1) { LAS unsigned char* nb = F.lds + ((it + 1) & 1) * 65536;
#pragma unroll
                for (int i = 0; i < 4; ++i) { *(LAS u32x4*)(nb + i * 16384 + kw) = kreg[i]; *(LAS u32x4*)(nb + i * 16384 + vw) = vreg[i]; } }
            if (kt >= 2) {
#pragma unroll
                for (int i = 0; i < 4; ++i) { kreg[i] = *(const u32x4*)(kvsrc + (size_t)(kt - 2) * 64 * PLD + C_KB + i * 64); vreg[i] = *(const u32x4*)(kvsrc + (size_t)(kt - 2) * 64 * PLD + C_VB + i * 64); } }
            if (F.lane == 0) flags[(it & 1) * 8 + F.wave] = mydone ? 1 : 0;
            __syncthreads();
            int alld = 1;
#pragma unroll
            for (int w = 0; w < 8; ++w) alld &= flags[(it & 1) * 8 + w];
            if (alld) break;
        }
        if (F8B) store_o_tile(o, (bf16*)((unsigned char*)(F.ws + WS_A2) + (size_t)T * 512 + (size_t)(b * SEQ + qw) * 512 + head * 64), F.lds + F.wave * 4096, F.lane);
        else store_o_tile(o, yb + (size_t)(b * SEQ + qw) * 512 + head * 64, F.lds + F.wave * 4096, F.lane);
    }
}

__device__ __forceinline__ void phase_mid(const Ctx& F) { const float* const p_x = F.in(0); const float* const p_gpost = F.in(5); const float* const p_gpre = F.in(12);
    const int gw = F.blk * NWAVES + F.wave, NGW = F.G * NWAVES;
    const float* mod = (const float*)(F.ws + WS_MOD);
    const bf16* o = (const bf16*)(F.ws + (F8O ? WS_A3 : WS_A1));
    bf16* h2 = (bf16*)(F.ws + WS_A2); bf16* xmid = (bf16*)(F.ws + WS_XMID);
    for (int ch = gw; ch < T / 16; ch += NGW) {
        const int row0 = ch * 16, b = row0 / SEQ;
        f32x4 gp[4], g2[4], s2[4];
#pragma unroll
        for (int j = 0; j < 4; ++j) { const int col = 4 * F.lane + 256 * j;
            gp[j] = *(const f32x4*)(p_gpost + col) * *(const f32x4*)(mod + b * 6144 + 2 * 1024 + col);
            g2[j] = *(const f32x4*)(p_gpre + col) * (*(const f32x4*)(mod + b * 6144 + 4 * 1024 + col) + 1.0f);
            s2[j] = *(const f32x4*)(mod + b * 6144 + 3 * 1024 + col); }
        for (int rr = 0; rr < 16; ++rr) {
            const size_t row = (size_t)(row0 + rr);
            f32x4 v[4], xv[4]; float s = 0.f;
#pragma unroll
            for (int j = 0; j < 4; ++j) { const u32x2 w = *(const u32x2*)(o + row * DM + 4 * F.lane + 256 * j);
                v[j] = (f32x4){bflo(w.x), bfhi(w.x), bflo(w.y), bfhi(w.y)}; xv[j] = *(const f32x4*)(p_x + row * DM + 4 * F.lane + 256 * j);
                s += (v[j].x * v[j].x + v[j].y * v[j].y) + (v[j].z * v[j].z + v[j].w * v[j].w); }
            const float r1 = 1.0f / sqrtf(wave_sum(s) * (1.f / DM) + RMS_EPS);
            float q = 0.f;
#pragma unroll
            for (int j = 0; j < 4; ++j) { xv[j] = xv[j] + v[j] * r1 * gp[j]; { u32x2 w; w.x = pk2(xv[j].x, xv[j].y); w.y = pk2(xv[j].z, xv[j].w); *(u32x2*)(xmid + row * DM + 4 * F.lane + 256 * j) = w; }
                q += (xv[j].x * xv[j].x + xv[j].y * xv[j].y) + (xv[j].z * xv[j].z + xv[j].w * xv[j].w); }
            const float r2 = 1.0f / sqrtf(wave_sum(q) * (1.f / DM) + RMS_EPS);
#pragma unroll
            for (int j = 0; j < 4; ++j) { const f32x4 hv = xv[j] * r2 * g2[j] + s2[j]; u32x2 w; w.x = pk2(hv.x, hv.y); w.y = pk2(hv.z, hv.w); *(u32x2*)(h2 + row * DM + 4 * F.lane + 256 * j) = w;
                if (MOE1_FP8) { int t8 = 0; t8 = __builtin_amdgcn_cvt_pk_fp8_f32(hv.x, hv.y, t8, false); t8 = __builtin_amdgcn_cvt_pk_fp8_f32(hv.z, hv.w, t8, true); *(unsigned*)(F.ws + WS_H2F8 + row * DM + 4 * F.lane + 256 * j) = (unsigned)t8; } }
        }
    }
}

__device__ __forceinline__ unsigned fkey(float v) { const unsigned k = __float_as_uint(v); return (k & 0x80000000u) ? ~k : (k | 0x80000000u); }
__device__ __forceinline__ int mbcnt64(unsigned long long b) { return (int)__builtin_amdgcn_mbcnt_hi((unsigned)(b >> 32), __builtin_amdgcn_mbcnt_lo((unsigned)b, 0u)); }
__device__ __forceinline__ void phase_route(const Ctx& F) { const float* const p_rb = F.in(15);
    const float* logits = (const float*)(F.ws + WS_A1);
    int* idxg = (int*)(F.ws + WS_IDX); float* wtg = (float*)(F.ws + WS_WT); int* rankg = (int*)(F.ws + WS_RANK);
    unsigned* bb = (unsigned*)(F.ws + WS_BB);
    unsigned* gcnt = (unsigned*)(F.ws + WS_CTL) + CW_GCNT;
    LAS int* hist = (LAS int*)(F.lds);
    __syncthreads();
    if (F.tid < NE) hist[F.tid] = 0;
    __syncthreads();
    const int tpb = (T + F.G - 1) / F.G, t0 = F.blk * tpb, t1 = (t0 + tpb < T) ? t0 + tpb : T;
    const f32x4 rb = *(const f32x4*)(p_rb + 4 * F.lane);
    for (int t = t0 + F.wave; t < t1; t += NWAVES) {
        const f32x4 lg = *(const f32x4*)(logits + (size_t)t * NE + 4 * F.lane);
        const float s0 = sigmoidf_(lg.x), s1 = sigmoidf_(lg.y), s2 = sigmoidf_(lg.z), s3 = sigmoidf_(lg.w);
        const float c0 = s0 + rb.x, c1 = s1 + rb.y, c2 = s2 + rb.z, c3 = s3 + rb.w;
        float m1 = fmaxf(c0, c1), m2 = fminf(c0, c1);
        m2 = fmaxf(m2, fminf(m1, c2)); m1 = fmaxf(m1, c2);
        m2 = fmaxf(m2, fminf(m1, c3)); m1 = fmaxf(m1, c3);
#pragma unroll
        for (int off = 1; off < 8; off <<= 1) { const float o1 = __shfl_xor(m1, off), o2 = __shfl_xor(m2, off);
            const float n2 = fmaxf(fminf(m1, o1), fmaxf(m2, o2)); m1 = fmaxf(m1, o1); m2 = n2; }
        const float gs = m1 + m2; const int mygrp = F.lane >> 3; int rk = 0;
#pragma unroll
        for (int g2 = 0; g2 < 8; ++g2) { const float og = __shfl(gs, 8 * g2); rk += ((og > gs) || (og == gs && g2 < mygrp)) ? 1 : 0; }
        const bool sel = rk < 4;
        const unsigned k0 = sel ? fkey(c0) : 0u, k1 = sel ? fkey(c1) : 0u, k2 = sel ? fkey(c2) : 0u, k3 = sel ? fkey(c3) : 0u;
        unsigned Tk = 0u;
#pragma unroll
        for (int bit = 31; bit >= 0; --bit) {
            const unsigned cand = Tk | (1u << bit);
            const int cnt = __builtin_popcountll(__ballot(k0 >= cand)) + __builtin_popcountll(__ballot(k1 >= cand)) + __builtin_popcountll(__ballot(k2 >= cand)) + __builtin_popcountll(__ballot(k3 >= cand));
            Tk = (cnt >= TOPK) ? cand : Tk;
        }
        const bool g0 = k0 > Tk, g1 = k1 > Tk, g2 = k2 > Tk, g3 = k3 > Tk, e0 = k0 == Tk, e1 = k1 == Tk, e2 = k2 == Tk, e3 = k3 == Tk;
        const int need = TOPK - (__builtin_popcountll(__ballot(g0)) + __builtin_popcountll(__ballot(g1)) + __builtin_popcountll(__ballot(g2)) + __builtin_popcountll(__ballot(g3)));
        int eqb = mbcnt64(__ballot(e0)) + mbcnt64(__ballot(e1)) + mbcnt64(__ballot(e2)) + mbcnt64(__ballot(e3));
        const bool x0 = g0 || (e0 && eqb < need); eqb += e0 ? 1 : 0;
        const bool x1 = g1 || (e1 && eqb < need); eqb += e1 ? 1 : 0;
        const bool x2 = g2 || (e2 && eqb < need); eqb += e2 ? 1 : 0;
        const bool x3 = g3 || (e3 && eqb < need);
        int pos = mbcnt64(__ballot(x0)) + mbcnt64(__ballot(x1)) + mbcnt64(__ballot(x2)) + mbcnt64(__ballot(x3));
        const float ssum = wave_sum((x0 ? s0 : 0.f) + (x1 ? s1 : 0.f) + (x2 ? s2 : 0.f) + (x3 ? s3 : 0.f));
        const float wsc = 2.5f / ssum;
#define ROUTE_EMIT(x, j, s) if (x) { const int e_ = 4 * F.lane + (j); const int rkl = __hip_atomic_fetch_add(hist + e_, 1, __ATOMIC_RELAXED, __HIP_MEMORY_SCOPE_WORKGROUP); \
            idxg[(size_t)t * TOPK + pos] = e_; wtg[(size_t)t * TOPK + pos] = (s) * wsc; rankg[(size_t)t * TOPK + pos] = rkl; ++pos; }
        ROUTE_EMIT(x0, 0, s0) ROUTE_EMIT(x1, 1, s1) ROUTE_EMIT(x2, 2, s2) ROUTE_EMIT(x3, 3, s3)
#undef ROUTE_EMIT
    }
    __syncthreads();
    if (F.tid < NE) bb[F.blk * NE + F.tid] = __hip_atomic_fetch_add(gcnt + F.tid, (unsigned)hist[F.tid], __ATOMIC_RELAXED, __HIP_MEMORY_SCOPE_AGENT);
}

__device__ __forceinline__ void phase_scatter(const Ctx& F) {
    const int* idxg = (const int*)(F.ws + WS_IDX); const float* wtg = (const float*)(F.ws + WS_WT); const int* rankg = (const int*)(F.ws + WS_RANK);
    int* posg = (int*)(F.ws + WS_POS); int* tokp = (int*)(F.ws + WS_TOKP); int* ypos = (int*)(F.ws + WS_YPOS); float* wpad = (float*)(F.ws + WS_WPAD);
    const unsigned* bb = (const unsigned*)(F.ws + WS_BB);
    const unsigned* gcnt = (const unsigned*)(F.ws + WS_CTL) + CW_GCNT;
    int* tile_e = (int*)(F.ws + WS_TILEE);
    LAS int* cnt = (LAS int*)(F.lds); LAS int* pst = cnt + 256; LAS int* cst = cnt + 512; LAS int* base = cnt + 768;
    __syncthreads();
    if (F.tid < NE) cnt[F.tid] = (int)__hip_atomic_load(gcnt + F.tid, __ATOMIC_RELAXED, __HIP_MEMORY_SCOPE_AGENT);
    __syncthreads();
    if (F.tid < NE) { int ps = 0, cs = 0; for (int e = 0; e < F.tid; ++e) { ps += (cnt[e] + 255) & ~255; cs += cnt[e]; } pst[F.tid] = ps; cst[F.tid] = cs; base[F.tid] = (int)bb[F.blk * NE + F.tid]; }
    __syncthreads();
    const int tpb = (T + F.G - 1) / F.G, t0 = F.blk * tpb, t1 = (t0 + tpb < T) ? t0 + tpb : T;
    for (int i = t0 * TOPK + F.tid; i < t1 * TOPK; i += NTHR) {
        const int e = idxg[i], r = rankg[i] + base[e], p = pst[e] + r, cp = cst[e] + r;
        tokp[p] = i >> 3; ypos[p] = cp; wpad[p] = wtg[i]; posg[i] = cp;
    }
    for (int e = F.blk; e < NE; e += F.G) {
        const int ps = pst[e], n = cnt[e], pe = ps + ((n + 255) & ~255);
        for (int p = ps + n + F.tid; p < pe; p += NTHR) { tokp[p] = -1; ypos[p] = -1; wpad[p] = 0.f; }
        for (int tl = ps / 256 + F.tid; tl < pe / 256; tl += NTHR) tile_e[tl] = e;
        if (e == NE - 1 && F.tid == 0) ((unsigned*)(F.ws + WS_CTL))[CW_NRT] = (unsigned)(pe / 256);
    }
    for (int t = F.blk * NTHR + F.tid; t < T; t += F.G * NTHR) { tokp[PADCAP + t] = t; ypos[PADCAP + t] = NASSIGN + t; wpad[PADCAP + t] = 1.0f; }
    for (int s = F.blk * NTHR + F.tid; s < T / 256; s += F.G * NTHR) tile_e[SH_TILE0 + s] = NE;
}

template <int STAGE> __device__ __forceinline__ void phase_moe(const Ctx& F) {
    const int* tokp = (const int*)(F.ws + WS_TOKP); const int* ypos = (const int*)(F.ws + WS_YPOS); const float* wpad = (const float*)(F.ws + WS_WPAD);
    const int* tile_e = (const int*)(F.ws + WS_TILEE);
    const int nrt = (int)__hip_atomic_load((unsigned*)(F.ws + WS_CTL) + CW_NRT, __ATOMIC_RELAXED, __HIP_MEMORY_SCOPE_AGENT);
    const int ntl = nrt + T / 256;
    const bf16* h2 = (const bf16*)(F.ws + WS_A2);
    bf16* hid = (bf16*)(F.ws + WS_A3);
    unsigned char* Y = (unsigned char*)(F.ws + WS_Y);
    const int r32 = F.lane & 31, hi = F.lane >> 5, wm = F.wave >> 2, wn = F.wave & 3;
    const int prow = F.tid >> 3, pch = F.tid & 7;
    constexpr int NPN = (STAGE == 1) ? 2 : 4, K = (STAGE == 1) ? 1024 : 256;
    const int nU = ntl * 2 * NPN;
    for (int u = F.blk; u < nU; u += F.G) {
        const int pn = u % NPN, hm = (u / NPN) & 1, tq = u / (2 * NPN);
        const int tile = tq < nrt ? tq : SH_TILE0 + (tq - nrt);
        const int e = tile_e[tile], p0 = tile * 256 + hm * 128;
        if (tokp[p0] < 0) continue;
        const char *pa0, *pa1;
        if (STAGE == 1) { int ta = tokp[p0 + prow], tb = tokp[p0 + prow + 64]; ta = ta < 0 ? 0 : ta; tb = tb < 0 ? 0 : tb;
            pa0 = (const char*)(h2 + (size_t)ta * DM) + pch * 16; pa1 = (const char*)(h2 + (size_t)tb * DM) + pch * 16; }
        else { pa0 = (const char*)(hid + (size_t)(p0 + prow) * EDIM) + pch * 16; pa1 = pa0 + 64 * EDIM * 2; }
        const bf16* Bt = (STAGE == 1) ? (const bf16*)(F.ws + WS_WGU) + (size_t)e * 512 * 1024 : (const bf16*)(F.ws + WS_WD) + (size_t)e * 1024 * 256;
        const char* pb0 = (const char*)(Bt + (size_t)(pn * 256 + prow) * K) + pch * 16;
        const size_t bs = (size_t)64 * K * 2;
        f32x16 acc[2][2];
        sg_mainloop(F.lds, pa0, pa1, pb0, pb0 + bs, pb0 + 2 * bs, pb0 + 3 * bs, K, acc);
#pragma unroll
        for (int mt = 0; mt < 2; ++mt) {
            const int p = p0 + wm * 64 + mt * 32 + r32;
            if (STAGE == 1) {
#pragma unroll
                for (int rg = 0; rg < 4; ++rg) {
                    float hv[4];
#pragma unroll
                    for (int q = 0; q < 4; ++q) { const float gt = acc[mt][0][4 * rg + q], up = acc[mt][1][4 * rg + q]; hv[q] = gt * sigmoidf_(gt) * up; }
                    u32x2 w; w.x = pk2(hv[0], hv[1]); w.y = pk2(hv[2], hv[3]);
                    *(u32x2*)(hid + (size_t)p * EDIM + pn * 128 + wn * 32 + 8 * rg + 4 * hi) = w;
                }
            } else {
                const int tk = tokp[p];
                if (tk >= 0) {
                    const float wv = wpad[p] * Y8_SCALE; unsigned char* yr = Y + (size_t)ypos[p] * DM + pn * 256;
#pragma unroll
                    for (int j = 0; j < 2; ++j)
#pragma unroll
                        for (int rg = 0; rg < 4; ++rg) { int t = 0; t = __builtin_amdgcn_cvt_pk_fp8_f32(acc[mt][j][4 * rg] * wv, acc[mt][j][4 * rg + 1] * wv, t, false);
                            t = __builtin_amdgcn_cvt_pk_fp8_f32(acc[mt][j][4 * rg + 2] * wv, acc[mt][j][4 * rg + 3] * wv, t, true);
                            *(unsigned*)(yr + j * 128 + wn * 32 + 8 * rg + 4 * hi) = (unsigned)t; }
                }
            }
        }
    }
}

__device__ __forceinline__ void phase_combine(const Ctx& F) { const float* const p_gff = F.in(13);
    const int gw = F.blk * NWAVES + F.wave, NGW = F.G * NWAVES;
    const float* mod = (const float*)(F.ws + WS_MOD);
    const int* posg = (const int*)(F.ws + WS_POS);
    const unsigned char* Y = (const unsigned char*)(F.ws + WS_Y); const bf16* xmid = (const bf16*)(F.ws + WS_XMID);
    typedef float f32x2 __attribute__((ext_vector_type(2)));
    for (int ch = gw; ch < T / 16; ch += NGW) {
        const int row0 = ch * 16, b = row0 / SEQ;
        f32x4 gg[4];
#pragma unroll
        for (int j = 0; j < 4; ++j) { const int col = 16 * F.lane + 4 * j; gg[j] = *(const f32x4*)(p_gff + col) * *(const f32x4*)(mod + b * 6144 + 5 * 1024 + col); }
        for (int rr = 0; rr < 16; ++rr) {
            const int t = row0 + rr;
            f32x4 y[4];
#pragma unroll
            for (int j = 0; j < 4; ++j) y[j] = (f32x4){0.f, 0.f, 0.f, 0.f};
            u32x4 w[TOPK + 1];
#pragma unroll
            for (int k = 0; k < TOPK + 1; ++k) { const size_t yr = (k < TOPK) ? (size_t)posg[(size_t)t * TOPK + k] : (size_t)(NASSIGN + t); w[k] = *(const u32x4*)(Y + yr * DM + 16 * F.lane); }
#pragma unroll
            for (int k = 0; k < TOPK + 1; ++k)
#pragma unroll
                for (int j = 0; j < 4; ++j) { const f32x2 lo = __builtin_amdgcn_cvt_pk_f32_fp8((int)w[k][j], false), hi = __builtin_amdgcn_cvt_pk_f32_fp8((int)w[k][j], true);
                    y[j] += (f32x4){lo.x, lo.y, hi.x, hi.y}; }
            float s = 0.f;
#pragma unroll
            for (int j = 0; j < 4; ++j) { y[j] = y[j] * (1.0f / Y8_SCALE); s += (y[j].x * y[j].x + y[j].y * y[j].y) + (y[j].z * y[j].z + y[j].w * y[j].w); }
            const float r = 1.0f / sqrtf(wave_sum(s) * (1.f / DM) + RMS_EPS);
            const u32x4 xw0 = *(const u32x4*)(xmid + (size_t)t * DM + 16 * F.lane), xw1 = *(const u32x4*)(xmid + (size_t)t * DM + 16 * F.lane + 8);
            const f32x4 xm[4] = {(f32x4){bflo(xw0.x), bfhi(xw0.x), bflo(xw0.y), bfhi(xw0.y)}, (f32x4){bflo(xw0.z), bfhi(xw0.z), bflo(xw0.w), bfhi(xw0.w)},
                                 (f32x4){bflo(xw1.x), bfhi(xw1.x), bflo(xw1.y), bfhi(xw1.y)}, (f32x4){bflo(xw1.z), bfhi(xw1.z), bflo(xw1.w), bfhi(xw1.w)}};
#pragma unroll
            for (int j = 0; j < 4; ++j) *(f32x4*)(F.out + (size_t)t * DM + 16 * F.lane + 4 * j) = xm[j] + y[j] * r * gg[j];
        }
    }
}

constexpr int NPHASE = 14;
struct Args { const float* in[22]; float* out; unsigned char* ws; int ph_lo, ph_hi, var, pad; };
__global__ void __launch_bounds__(NTHR, 2) fwd(Args args) {
    extern __shared__ __attribute__((aligned(16))) unsigned char lds[];
    Ctx F;
    F.lds = (LAS unsigned char*)lds;
    F.tid = threadIdx.x; F.lane = F.tid & 63; F.wave = __builtin_amdgcn_readfirstlane(F.tid >> 6); F.G = gridDim.x; F.blk = blockIdx.x;
    F.out = args.out; F.ws = args.ws;
    volatile LAS unsigned* misc = (volatile LAS unsigned*)(F.lds + LDS_BYTES - 64);
    if (F.tid < 16) misc[F.tid] = 0u;
    __syncthreads();
    const int lo = args.ph_lo, hi = args.ph_hi;
    XcdBarrier bar; bar.bar = (unsigned*)(F.ws + WS_CTL) + CW_BAR; bar.x = 0; bar.st = nullptr;
    if (hi - lo > 1) bar = xcd_barrier_post((unsigned*)(F.ws + WS_CTL) + CW_BAR, misc);
#define IN(k) (lo <= (k) && (k) < hi)
#define SEAM(k) do { if (IN(k) && IN((k) + 1)) xcd_barrier(bar); } while (0)
#define SEAMW(k, gu, r) do { if (IN(k) && IN((k) + 1)) { if (NEW_CVT && !CVT_IN_P0 && (r) * 2048 < ((gu) ? CVT_GB : CVT_DB)) { xcd_arrive(bar); cvt_experts<gu>(F, F.lds + F.wave * 8448, (r) * 2048, ((r) + 1) * 2048); xcd_wait(bar); } else xcd_barrier(bar); } } while (0)
    if (IN(0)) { phase_prologue(F); } SEAMW(0, true, 0);
    if (IN(1)) { phase_h(F); } SEAMW(1, true, 1);
    if (IN(2)) { if (FAST_DENSE) phase_dense_fast<0>(F); else phase_dense<0>(F); } SEAMW(2, true, 2);
    if (IN(3)) {
        if (NEW_CVT && !CVT_IN_P0 && !(F.blk & 1)) { cvt_experts<true>(F, F.lds + F.wave * 8448, CVT_G1, N_GU_ITEMS); __syncthreads(); }
        phase_swa(F); if (PROBE_ATT == 1) phase_swa(F); phase_sb(F); if (PROBE_ATT == 2) phase_sb(F);
        if (NEW_CVT && !CVT_IN_P0 && (F.blk & 1)) { __syncthreads(); cvt_experts<true>(F, F.lds + F.wave * 8448, CVT_G1, N_GU_ITEMS); }
    } SEAMW(3, true, 3);
    if (IN(4)) { if (FAST_DENSE) phase_dense_fast<1>(F); else phase_dense<1>(F); }
    if (IN(5)) { if (FAST_DENSE) phase_dense_fast<2>(F); else phase_dense<2>(F); } SEAMW(5, false, 0);
    if (IN(6)) { if (FAST_DENSE) phase_dense_fast<3>(F); else phase_dense<3>(F); } SEAMW(6, false, 1);
    if (IN(7)) { phase_mid(F); } SEAMW(7, false, 2);
    if (IN(8)) {
        if (FAST_DENSE) phase_dense_fast<4>(F); else phase_dense<4>(F);
        if (NEW_CVT && !CVT_IN_P0) { if (F.G == 256) { if (F.blk >= 128) cvt_experts_from<false>(F, F.lds + F.wave * 8448, CVT_DB + (F.blk - 128) * NWAVES + F.wave, 1024, N_D_ITEMS); }
                                     else cvt_experts<false>(F, F.lds + F.wave * 8448, CVT_DB, N_D_ITEMS); }
    } SEAMW(8, false, 3);
    if (IN(9)) { phase_route(F); } SEAMW(9, true, 4);
    if (IN(10)) { phase_scatter(F); } SEAM(10);
    if (IN(11)) { if (FAST_MOE) phase_moe_fast<1>(F); else phase_moe<1>(F); } SEAM(11);
    if (IN(12)) { if (FAST_MOE) phase_moe_fast<2>(F); else phase_moe<2>(F); } SEAM(12);
    if (IN(13)) { phase_combine(F); }
#undef IN
#undef SEAM
}

extern "C" void kernel_launch(void* const* d_in, const int* in_sizes, int n_in, void* d_out, int out_size, void* d_ws, size_t ws_size, hipStream_t stream) {
    static int grid = 0;
    if (grid == 0) {
        if (n_in != 22 || in_sizes[0] != T * DM || out_size != T * DM || ws_size < WS_END) { fprintf(stderr, "kernel_launch: unexpected shapes (n_in %d, in0 %d, out %d, ws %zu); nothing launched\n", n_in, n_in > 0 ? in_sizes[0] : -1, out_size, ws_size); grid = -1; return; }
        int dev = 0, cus = 0, per_cu = 0;
        if (hipGetDevice(&dev) != hipSuccess || hipDeviceGetAttribute(&cus, hipDeviceAttributeMultiprocessorCount, dev) != hipSuccess) { grid = -1; return; }
        if (hipFuncSetAttribute((const void*)fwd, hipFuncAttributeMaxDynamicSharedMemorySize, LDS_BYTES) != hipSuccess) { grid = -1; return; }
        if (hipOccupancyMaxActiveBlocksPerMultiprocessor(&per_cu, (const void*)fwd, NTHR, LDS_BYTES) != hipSuccess || per_cu < 1) { fprintf(stderr, "kernel_launch: occupancy query says %d\n", per_cu); }
        (void)hipGetLastError();
        grid = cus;
    }
    if (grid < 0) return;
    (void)hipMemsetAsync((char*)d_ws + WS_CTL, 0, CTL_ZERO_BYTES, stream);
    Args a{};
    for (int i = 0; i < 22; ++i) a.in[i] = (const float*)d_in[i];
    a.out = (float*)d_out; a.ws = (unsigned char*)d_ws;
#if MK_ONE_LAUNCH
    a.ph_lo = 0; a.ph_hi = NPHASE;
    hipLaunchKernelGGL(fwd, dim3(grid), dim3(NTHR), LDS_BYTES, stream, a);
    if (PROBE_MOE2) { a.ph_lo = 12; a.ph_hi = 13; a.var = PROBE_MOE2; hipLaunchKernelGGL(fwd, dim3(grid), dim3(NTHR), LDS_BYTES, stream, a); }
#else
    for (int p = 0; p < NPHASE; ++p) { a.ph_lo = p; a.ph_hi = p + 1; hipLaunchKernelGGL(fwd, dim3(grid), dim3(NTHR), LDS_BYTES, stream, a); }
#endif
}
```

```cpp
#include <hip/hip_runtime.h>
#include <cstdio>
#include <cstdint>

#ifndef FAST_DENSE
#define FAST_DENSE 1
#endif
#ifndef FAST_MOE
#define FAST_MOE 1
#endif
#ifndef NEW_CVT
#define NEW_CVT 1
#endif
#ifndef CVT_IN_P0
#define CVT_IN_P0 0
#endif
#ifndef MOE1_FP8
#define MOE1_FP8 1
#endif
#ifndef MOE2_FP8
#define MOE2_FP8 1
#endif
#ifndef F8G
#define F8G 0
#endif
#ifndef F8B
#define F8B 0
#endif
#ifndef F8O
#define F8O 0
#endif
#ifndef SPREAD_D9
#define SPREAD_D9 0
#define SPREAD_D8A 0
#define SPREAD_D8B 0
#endif
#ifndef INPROJ_LATE_US
#define INPROJ_LATE_US 0
#endif
#ifndef P2_CVT_HI
#define P2_CVT_HI (CVT_STAGGER ? 22 : 11)
#endif
#ifndef EPI_NT
#define EPI_NT 1
#endif
#ifndef FUSE_BR
#define FUSE_BR 1
#endif
#ifndef MOE2_PAIR
#define MOE2_PAIR 1
#endif
#ifndef INPROJ_QUAD
#define ATT_XCD 1
#define CVT_REP 1
#ifndef PROBE_MOE2
#define PROBE_MOE2 0
#ifndef STAGE_OPQ
#define STAGE_OPQ 1
#endif
#ifndef SB_V2
#define SB_V2 1
#endif
#ifndef HOIST_W2
#define HOIST_W2 1
#endif
#endif
#ifndef PROBE_ATT
#define PROBE_ATT 0
#endif
#ifndef CVT_DEPTH
#define CVT_DEPTH 2
#endif
#define PROBE_CVT32 0
#ifndef CVT_STAGGER
#define CVT_STAGGER 0
#endif
#define INPROJ_QUAD 0
#endif
#ifndef MK_ONE_LAUNCH
#define MK_ONE_LAUNCH 1
#endif

#define GAS __attribute__((address_space(1)))
#define LAS __attribute__((address_space(3)))
typedef unsigned short bf16;
typedef float f32x4 __attribute__((ext_vector_type(4)));
typedef float f32x16 __attribute__((ext_vector_type(16)));
typedef short bf16x8 __attribute__((ext_vector_type(8)));
typedef short s16x4 __attribute__((ext_vector_type(4)));
typedef unsigned u32x4 __attribute__((ext_vector_type(4)));
typedef unsigned u32x2 __attribute__((ext_vector_type(2)));
typedef GAS unsigned gu32;

constexpr int NB = 16, SEQ = 2048, DM = 1024, T = NB * SEQ;
constexpr int INW = 4352;
constexpr int PLD = INW + 64;
constexpr int C_QA = 0, C_KA = 512, C_VA = 640, C_QB = 768, C_KB = 1280, C_VB = 1792, C_GA = 2304, C_GB = 3328;
constexpr int NE = 256, TOPK = 8, EDIM = 256;
constexpr int NASSIGN = T * TOPK;
constexpr int PADCAP = NASSIGN + NE * 256;
constexpr int NROWS_PAD = PADCAP + T;
constexpr int SH_TILE0 = PADCAP / 256;
constexpr float RMS_EPS = 1e-6f;
constexpr float LOG2E = 1.4426950408889634f;
constexpr float Y8_SCALE = 8.0f;
constexpr float ATT8_SCALE = 4.0f, MRG8_SCALE = 8.0f;
constexpr float HID8_SCALE = 4.0f;
constexpr float W8_SCALE = 64.0f;
constexpr int NWAVES = 8, NTHR = 512;
constexpr int LDS_BYTES = 147456;

constexpr size_t MiB = 1u << 20;
constexpr size_t WS_CTL = 0, CTL_ZERO_BYTES = 1 * MiB;
constexpr size_t WS_MOD = 1 * MiB;
constexpr size_t WS_BB = 2 * MiB;
constexpr size_t WS_TILEE = 3 * MiB;
constexpr size_t WS_WIN = 4 * MiB;
constexpr size_t WS_WIN8 = 9 * MiB;
constexpr size_t WS_WA = 13 * MiB, WS_WB = 14 * MiB, WS_WOUT = 15 * MiB, WS_WR = 17 * MiB;
constexpr size_t WS_WD = 20 * MiB;
constexpr size_t WS_WGU = 149 * MiB;
constexpr size_t WS_Y = 149 * MiB;
constexpr size_t WS_PROJ = 400 * MiB;
constexpr size_t WS_H2F8 = 564 * MiB;
constexpr size_t WS_XMID = 500 * MiB;
constexpr size_t WS_A1 = 678 * MiB;
constexpr size_t WS_A2 = 742 * MiB;
constexpr size_t WS_A3 = 806 * MiB;
constexpr size_t WS_IDX = 982 * MiB, WS_WT = 983 * MiB, WS_RANK = 984 * MiB, WS_POS = 985 * MiB;
constexpr size_t WS_TOKP = 986 * MiB, WS_YPOS = 988 * MiB, WS_WPAD = 990 * MiB, WS_END = 992 * MiB;
static_assert(WS_WD + (size_t)257 * 1024 * 256 * 2 <= WS_WGU, "wd");
static_assert(WS_WGU + (size_t)257 * 512 * 1024 * (MOE1_FP8 ? 1 : 2) <= WS_PROJ, "wgu");
static_assert(WS_PROJ + (size_t)T * PLD * 2 <= WS_A1, "proj");
static_assert(WS_Y + (size_t)(NASSIGN + T + 1) * 1024 <= WS_XMID, "y");
static_assert(WS_A3 + (size_t)NROWS_PAD * 256 * 2 <= WS_IDX, "hid");
static_assert(WS_TOKP + (size_t)NROWS_PAD * 4 <= WS_YPOS && WS_YPOS + (size_t)NROWS_PAD * 4 <= WS_WPAD && WS_WPAD + (size_t)NROWS_PAD * 4 <= WS_END, "pad arrays");
constexpr int CW_BAR = 4096;
constexpr int CW_GCNT = 16384;
constexpr int CW_NRT = 16384 + 256;

__device__ const unsigned char T5B[384] = {
15,15,15,15,15,15,15,15,15,15,15,15,15,15,15,15,15,15,15,15,15,15,15,15,15,15,15,15,15,15,15,15,15,15,15,15,15,15,15,15,15,15,15,15,15,15,15,15,15,15,15,15,15,15,15,15,15,15,15,15,15,15,15,15,15,15,15,15,15,15,15,15,15,15,15,15,15,15,15,15,15,15,15,15,15,15,15,15,15,15,15,15,15,15,15,15,15,15,15,15,15,15,15,15,15,15,15,15,15,15,15,15,15,15,15,15,15,15,15,15,15,15,15,15,15,15,15,15,15,15,15,15,15,15,15,15,15,15,15,15,15,15,15,15,15,15,15,15,15,15,15,15,15,15,15,15,15,15,15,15,15,15,15,15,15,14,14,14,14,14,14,14,14,14,14,14,14,14,14,14,14,14,14,14,14,14,14,14,14,14,14,14,13,13,13,13,13,13,13,13,13,13,13,13,13,13,13,13,13,13,12,12,12,12,12,12,12,12,12,12,12,12,12,12,11,11,11,11,11,11,11,11,11,10,10,10,10,10,10,10,9,9,9,9,8,8,8,8,7,6,5,4,3,2,1,0,17,18,19,20,21,22,23,24,24,24,24,25,25,25,25,26,26,26,26,26,26,26,27,27,27,27,27,27,27,27,27,28,28,28,28,28,28,28,28,28,28,28,28,28,28,29,29,29,29,29,29,29,29,29,29,29,29,29,29,29,29,29,29,30,30,30,30,30,30,30,30,30,30,30,30,30,30,30,30,30,30,30,30,30,30,30,30,30,30,30,31,31,31,31,31,31,31,31,31,31,31,31,31,31,31,31,31,31,31,31,31,31,31,31,31,31,31,31,31,31,31,31,31,31,31,31,31,0};

#define LDS_WAIT() asm volatile("s_waitcnt lgkmcnt(0)" ::: "memory")
__device__ __forceinline__ unsigned f2bf(float f) { unsigned u = __builtin_bit_cast(unsigned, f); return (u + 0x7fffu + ((u >> 16) & 1u)) >> 16; }
__device__ __forceinline__ unsigned pk2(float lo, float hi) { return f2bf(lo) | (f2bf(hi) << 16); }
__device__ __forceinline__ float bf2f(unsigned short b) { return __builtin_bit_cast(float, (unsigned)b << 16); }
__device__ __forceinline__ float bflo(unsigned w) { return __builtin_bit_cast(float, w << 16); }
__device__ __forceinline__ float bfhi(unsigned w) { return __builtin_bit_cast(float, w & 0xffff0000u); }
__device__ __forceinline__ float clamp8(float v) { return __builtin_amdgcn_fmed3f(v, -448.0f, 448.0f); }
__device__ __forceinline__ float ex2(float x) { return __builtin_amdgcn_exp2f(x); }
__device__ __forceinline__ float lg2(float x) { return __builtin_amdgcn_logf(x); }
__device__ __forceinline__ float sigmoidf_(float x) { return __builtin_amdgcn_rcpf(1.0f + ex2(-x * LOG2E)); }
__device__ __forceinline__ float wave_sum(float v) {
#pragma unroll
    for (int o = 1; o < 64; o <<= 1) v += __shfl_xor(v, o);
    return v;
}
__device__ __forceinline__ int crow(int r, int hi) { return (r & 3) + 8 * (r >> 2) + 4 * hi; }
__device__ __forceinline__ s16x4 vtr(const LAS unsigned char* p) {
    typedef short v4i16_t __attribute__((ext_vector_type(4)));
    return __builtin_bit_cast(s16x4, __builtin_amdgcn_ds_read_tr16_b64_v4i16((LAS v4i16_t*)p));
}

#define XB_TMO      128
#define XB_XCNT(j)  (256  + 64 * (j))
#define XB_XSUB(j)  (1280 + 64 * (j))
#define XB_XGEN(j)  (2304 + 64 * (j))
#define XB_TOP      3328
#define XB_TOPGEN   3392
#define XCD_BAR_WORDS 3456
#define XB_SPIN_CAP (1u << 18)
__device__ __forceinline__ unsigned xb_ld(unsigned* p)              { return __hip_atomic_load(p, __ATOMIC_RELAXED, __HIP_MEMORY_SCOPE_AGENT); }
__device__ __forceinline__ unsigned xb_add(unsigned* p, unsigned v) { return __hip_atomic_fetch_add(p, v, __ATOMIC_RELAXED, __HIP_MEMORY_SCOPE_AGENT); }
__device__ __forceinline__ unsigned xb_xcc_id() { return (unsigned)__builtin_amdgcn_s_getreg((3 << 11) | 20) & 0xFu; }
#define XB_SPIN(cond, bar) do { unsigned _sp = 0; while (cond) { __builtin_amdgcn_s_sleep(1); \
    if ((++_sp & 255u) == 0u) { if (xb_ld(&(bar)[XB_TMO])) break; if (_sp > XB_SPIN_CAP) { atomicAdd(&(bar)[XB_TMO], 1u); break; } } } } while (0)
struct XcdBarrier { unsigned* bar; unsigned x; volatile LAS unsigned* st; };
__device__ __forceinline__ XcdBarrier xcd_barrier_post(unsigned* bar, volatile LAS unsigned* st) {
    XcdBarrier b; b.bar = bar; b.x = xb_xcc_id(); b.st = st;
    if (threadIdx.x == 0) (void)xb_add(&bar[XB_XCNT(b.x)], 1u);
    return b;
}
__device__ __forceinline__ void xcd_barrier_complete(unsigned* bar, unsigned x, unsigned& nloc, unsigned& nx) {
    const unsigned G = gridDim.x * gridDim.y * gridDim.z;
    unsigned sum, cnt, mine, sp = 0u;
    for (;;) {
        sum = 0u; cnt = 0u; mine = 0u;
#pragma unroll
        for (unsigned j = 0; j < 16; ++j) { const unsigned c = xb_ld(&bar[XB_XCNT(j)]); sum += c; cnt += (c > 0u) ? 1u : 0u; mine = (j == x) ? c : mine; }
        if (sum == G) break;
        __builtin_amdgcn_s_sleep(1);
        if ((++sp & 255u) == 0u) { if (xb_ld(&bar[XB_TMO])) break; if (sp > XB_SPIN_CAP) { atomicAdd(&bar[XB_TMO], 1u); break; } }
    }
    nloc = mine > 0u ? mine : 1u; nx = cnt > 0u ? cnt : 1u;
}
__device__ __forceinline__ void xcd_barrier(const XcdBarrier& b) {
    asm volatile("s_waitcnt vmcnt(0)" ::: "memory");
    __syncthreads();
    if (threadIdx.x == 0) {
        unsigned* bar = b.bar;
        __builtin_amdgcn_s_waitcnt(0);
        unsigned nloc = b.st[0], nx = b.st[1];
        if (nloc == 0u) { xcd_barrier_complete(bar, b.x, nloc, nx); b.st[0] = nloc; b.st[1] = nx; }
        const unsigned old = xb_add(&bar[XB_XSUB(b.x)], 1u);
        const unsigned gen = old / nloc;
        if (old + 1u == (gen + 1u) * nloc) {
            __builtin_amdgcn_fence(__ATOMIC_RELEASE, "agent");
            asm volatile("s_waitcnt vmcnt(0)" ::: "memory");
            const unsigned og = xb_add(&bar[XB_TOP], 1u);
            const unsigned tg = og / nx;
            if (og + 1u == (tg + 1u) * nx) xb_add(&bar[XB_TOPGEN], 1u);
            else XB_SPIN(xb_ld(&bar[XB_TOPGEN]) == tg, bar);
            __builtin_amdgcn_fence(__ATOMIC_ACQUIRE, "agent");
            xb_add(&bar[XB_XGEN(b.x)], 1u);
            asm volatile("s_waitcnt vmcnt(0)" ::: "memory");
        } else {
            XB_SPIN(xb_ld(&bar[XB_XGEN(b.x)]) == gen, bar);
            __builtin_amdgcn_fence(__ATOMIC_ACQUIRE, "agent");
            asm volatile("s_waitcnt vmcnt(0)" ::: "memory");
        }
    }
    __syncthreads();
}

__device__ __forceinline__ void xcd_arrive(const XcdBarrier& b) {
    asm volatile("s_waitcnt vmcnt(0)" ::: "memory");
    __syncthreads();
    if (threadIdx.x == 0) {
        unsigned* bar = b.bar;
        __builtin_amdgcn_s_waitcnt(0);
        unsigned nloc = b.st[0], nx = b.st[1];
        if (nloc == 0u) { xcd_barrier_complete(bar, b.x, nloc, nx); b.st[0] = nloc; b.st[1] = nx; }
        const unsigned old = xb_add(&bar[XB_XSUB(b.x)], 1u);
        const unsigned gen = old / nloc;
        unsigned role = 0u, tg = 0u;
        if (old + 1u == (gen + 1u) * nloc) {
            __builtin_amdgcn_fence(__ATOMIC_RELEASE, "agent");
            asm volatile("s_waitcnt vmcnt(0)" ::: "memory");
            const unsigned og = xb_add(&bar[XB_TOP], 1u);
            tg = og / nx; role = (og + 1u == (tg + 1u) * nx) ? 2u : 1u;
        }
        b.st[2] = gen; b.st[3] = tg; b.st[4] = role;
    }
}
__device__ __forceinline__ void xcd_wait(const XcdBarrier& b) {
    if (threadIdx.x == 0) {
        unsigned* bar = b.bar; const unsigned gen = b.st[2], tg = b.st[3], role = b.st[4];
        if (role != 0u) {
            if (role == 2u) xb_add(&bar[XB_TOPGEN], 1u);
            else XB_SPIN(xb_ld(&bar[XB_TOPGEN]) == tg, bar);
            __builtin_amdgcn_fence(__ATOMIC_ACQUIRE, "agent");
            xb_add(&bar[XB_XGEN(b.x)], 1u);
            asm volatile("s_waitcnt vmcnt(0)" ::: "memory");
        } else {
            XB_SPIN(xb_ld(&bar[XB_XGEN(b.x)]) == gen, bar);
            __builtin_amdgcn_fence(__ATOMIC_ACQUIRE, "agent");
            asm volatile("s_waitcnt vmcnt(0)" ::: "memory");
        }
    }
    __syncthreads();
}

struct Ctx {
    LAS unsigned char* lds;
    int tid, lane, wave, G, blk;
    float* out; unsigned char* ws;
    __device__ __forceinline__ const float* in(int i) const {
#if defined(__HIP_DEVICE_COMPILE__)
        const void* k = (const void*)__builtin_amdgcn_kernarg_segment_ptr(); asm volatile("" : "+s"(k));
        const GAS float* g = ((const GAS float* const*)k)[i]; return (const float*)g;
#else
        return nullptr;
#endif
    }
    __device__ __forceinline__ int karg_int(int idx) const {
#if defined(__HIP_DEVICE_COMPILE__)
        const void* k = (const void*)__builtin_amdgcn_kernarg_segment_ptr(); asm volatile("" : "+s"(k));
        return ((const GAS int*)k)[idx];
#else
        return 0;
#endif
    }
};

__device__ __forceinline__ void sg_mainloop(LAS unsigned char* lds, const char* pa0, const char* pa1, const char* pb0, const char* pb1, const char* pb2, const char* pb3,
                                            int K, f32x16 (&acc)[2][2]) {
    const int tid = threadIdx.x, lane = tid & 63, wave = tid >> 6, r32 = lane & 31, hi = lane >> 5, wm = wave >> 2, wn = wave & 3;
#pragma unroll
    for (int a = 0; a < 2; ++a)
#pragma unroll
        for (int b = 0; b < 2; ++b)
#pragma unroll
            for (int r = 0; r < 16; ++r) acc[a][b][r] = 0.f;
    const int prow = tid >> 3, pch = tid & 7;
    const unsigned wa0 = pch * 2048 + prow * 16, wa1 = pch * 2048 + (prow + 64) * 16;
    const unsigned wb0 = 16384 + pch * 4096 + prow * 16;
    u32x4 va0, va1, vb0, vb1, vb2, vb3;
    va0 = *(const u32x4*)pa0; va1 = *(const u32x4*)pa1; vb0 = *(const u32x4*)pb0; vb1 = *(const u32x4*)pb1; vb2 = *(const u32x4*)pb2; vb3 = *(const u32x4*)pb3;
    for (int k0 = 0; k0 < K; k0 += 64) {
        __syncthreads();
        *(LAS u32x4*)(lds + wa0) = va0; *(LAS u32x4*)(lds + wa1) = va1;
        *(LAS u32x4*)(lds + wb0) = vb0; *(LAS u32x4*)(lds + wb0 + 1024) = vb1; *(LAS u32x4*)(lds + wb0 + 2048) = vb2; *(LAS u32x4*)(lds + wb0 + 3072) = vb3;
        __syncthreads();
        if (k0 + 64 < K) {
            const int o = (k0 + 64) * 2;
            va0 = *(const u32x4*)(pa0 + o); va1 = *(const u32x4*)(pa1 + o); vb0 = *(const u32x4*)(pb0 + o); vb1 = *(const u32x4*)(pb1 + o); vb2 = *(const u32x4*)(pb2 + o); vb3 = *(const u32x4*)(pb3 + o);
        }
#pragma unroll
        for (int ks = 0; ks < 4; ++ks) {
            bf16x8 af[2], bfv[2];
#pragma unroll
            for (int mt = 0; mt < 2; ++mt) af[mt] = *(const LAS bf16x8*)(lds + (2 * ks + hi) * 2048 + (wm * 64 + mt * 32 + r32) * 16);
#pragma unroll
            for (int j = 0; j < 2; ++j) bfv[j] = *(const LAS bf16x8*)(lds + 16384 + (2 * ks + hi) * 4096 + (j * 128 + wn * 32 + r32) * 16);
#pragma unroll
            for (int mt = 0; mt < 2; ++mt)
#pragma unroll
                for (int j = 0; j < 2; ++j) acc[mt][j] = __builtin_amdgcn_mfma_f32_32x32x16_bf16(bfv[j], af[mt], acc[mt][j], 0, 0, 0);
        }
    }
}


namespace pg8 {
constexpr int BM = 256, BK = 64, HALF = 128, HTB = HALF * BK * 2, NXCD = 8, WGM = 8;
__host__ __device__ __forceinline__ int lds_byte(int r, int c) { const int st = (r >> 4) * 2 + (c >> 5), rr = r & 15, cc = c & 31, ob = rr * 64 + cc * 2; return st * 1024 + (ob ^ (((ob >> 9) & 1) << 5)); }
__host__ __device__ __forceinline__ void stage_rc(int b, int& R, int& C) { const int st = b / 1024, sb = b % 1024, swz = sb ^ (((sb >> 9) & 1) << 5); R = (st >> 1) * 16 + swz / 64; C = (st & 1) * 32 + (swz % 64) / 2; }
__host__ __device__ __forceinline__ int perm32(int rho) { const int n = rho >> 4, i = rho & 15; return 8 * (i >> 2) + 4 * n + (i & 3); }
struct Unit { int pm, pn, e; const LAS unsigned char* meta; };
__device__ __forceinline__ unsigned cvt_pk_bf16(float lo, float hi) { unsigned r; asm volatile("v_cvt_pk_bf16_f32 %0, %1, %2" : "=v"(r) : "v"(lo), "v"(hi)); return r; }

template <class Epi, class Sched, bool ALIGN_EPI, bool F8 = false, int SEGN = 1>
__device__ __forceinline__ void gemm_phase(LAS unsigned char* lds, const int K, const Sched& S, const Epi& E) {
    const int tid = threadIdx.x, wid = __builtin_amdgcn_readfirstlane(tid >> 6), lane = tid & 63, wr = wid >> 2, wc = wid & 3, fr = lane & 15, fq = lane >> 4;
    const int nt = K / BK;
    constexpr bool HOIST = HOIST_W2 == 3 || (HOIST_W2 && Sched::META == 0);
    constexpr bool ALLR = [] { if constexpr (SEGN > 1) return (bool)(HOIST_W2 == 2 && Epi::ALLTRIPS); else return false; }();
    int Rr[2], Cc[2]; unsigned voffB[2];
#pragma unroll
    for (int i = 0; i < 2; ++i) { stage_rc(tid * 16 + i * 8192, Rr[i], Cc[i]); const int R = Rr[i];
        const int Rb = (int)Epi::PERM == 1 ? ((R & ~31) + perm32(R & 31)) : (int)Epi::PERM == 2 ? (64 * (R >> 5) + 16 * ((R >> 2) & 3) + 4 * ((R >> 4) & 1) + (R & 3)) :
                       (int)Epi::PERM == 3 ? (64 * (R >> 5) + 8 * ((R >> 2) & 3) + 4 * ((R >> 4) & 1) + (R & 3)) : R;
        voffB[i] = (unsigned)(Rb * (K / SEGN) + Cc[i]) * 2u; }
    const size_t kstep = (size_t)(BK * 2);
    const size_t hstep = (size_t)((int)Epi::PERM == 2 ? 8 : (int)Epi::PERM == 3 ? 32 : HALF) * (K / SEGN) * 2;
    const unsigned ldsw = (unsigned)wid * 1024u;
    const int aoff = lds_byte(wr * 64 + fr, fq * 8), boff = lds_byte(wc * 32 + fr, fq * 8);
#define PG8_SA(b, h) (((b) * 2 + (h)) * HTB)
#define PG8_SB(b, h) ((4 + (b) * 2 + (h)) * HTB)
#define PG8_STAGE(bufoff, gbase, voff) do { const char* gb_ = (const char*)(gbase); asm volatile("" : "+s"(gb_));     \
        _Pragma("unroll") for (int _i = 0; _i < 2; ++_i) { unsigned vv_ = (voff)[_i]; if (STAGE_OPQ) asm volatile("" : "+v"(vv_));     \
        __builtin_amdgcn_global_load_lds((const unsigned*)(gb_ + vv_), (LAS unsigned*)(lds + (bufoff) + ldsw + _i * 8192), 16, 0, 0); } } while (0)
#define PG8_LDA(dst, b, h) do { _Pragma("unroll") for (int m = 0; m < 4; ++m) _Pragma("unroll") for (int k = 0; k < 2; ++k) dst[m][k] = *(const LAS bf16x8*)(lds + PG8_SA(b, h) + aoff + m * 2048 + k * 1024); } while (0)
#define PG8_LDB(dst, b, h) do { _Pragma("unroll") for (int n = 0; n < 2; ++n) _Pragma("unroll") for (int k = 0; k < 2; ++k) dst[n][k] = *(const LAS bf16x8*)(lds + PG8_SB(b, h) + boff + n * 2048 + k * 1024); } while (0)
#define PG8_MMA(ai, bj, At, Bt) do { __builtin_amdgcn_s_setprio(1); _Pragma("unroll") for (int m = 0; m < 4; ++m) _Pragma("unroll") for (int n = 0; n < 2; ++n) { \
        if constexpr (F8) { typedef int i32x8_ __attribute__((ext_vector_type(8))); typedef int i32x4_ __attribute__((ext_vector_type(4))); \
            const i32x4_ a0_ = __builtin_bit_cast(i32x4_, At[m][0]), a1_ = __builtin_bit_cast(i32x4_, At[m][1]), b0_ = __builtin_bit_cast(i32x4_, Bt[n][0]), b1_ = __builtin_bit_cast(i32x4_, Bt[n][1]); \
            const i32x8_ av_ = {a0_[0], a0_[1], a0_[2], a0_[3], a1_[0], a1_[1], a1_[2], a1_[3]}, bv_ = {b0_[0], b0_[1], b0_[2], b0_[3], b1_[0], b1_[1], b1_[2], b1_[3]}; \
            acc[ai][bj][m][n] = __builtin_amdgcn_mfma_scale_f32_16x16x128_f8f6f4(bv_, av_, acc[ai][bj][m][n], 0, 0, 0, 0, 0, 0); }         \
        else { _Pragma("unroll") for (int k = 0; k < 2; ++k) acc[ai][bj][m][n] = __builtin_amdgcn_mfma_f32_16x16x32_bf16(Bt[n][k], At[m][k], acc[ai][bj][m][n], 0, 0, 0); } } \
        __builtin_amdgcn_s_setprio(0); } while (0)
#define PG8_WAIT_V(n) asm volatile("s_waitcnt vmcnt(" #n ")" ::: "memory")
#define PG8_WAIT_VR(relax) do { if (relax) asm volatile("s_waitcnt vmcnt(%0)" :: "n"(8 + Epi::NSTORE) : "memory"); else asm volatile("s_waitcnt vmcnt(8)" ::: "memory"); } while (0)
#define PG8_WAIT_L(n) asm volatile("s_waitcnt lgkmcnt(" #n ")" ::: "memory")
#define PG8_BAR __builtin_amdgcn_s_barrier()
#define PG8_SCHED __builtin_amdgcn_sched_barrier(0)
#define PG8_LOADVO(dst, u) do { _Pragma("unroll") for (int _h = 0; _h < 2; ++_h) _Pragma("unroll") for (int _i = 0; _i < 2; ++_i) dst[_h][_i] = S.a_off(u, _h * HALF + Rr[_i]) + (unsigned)Cc[_i] * 2u; } while (0)
    Unit cur, nxt; int ui = 0;
    if (!S.next(0, cur)) return;
    f32x4 acc[2][2][4][2];
#pragma unroll
    for (int a = 0; a < 2; ++a)
#pragma unroll
        for (int b = 0; b < 2; ++b)
#pragma unroll
            for (int m = 0; m < 4; ++m)
#pragma unroll
                for (int n = 0; n < 2; ++n) acc[a][b][m][n] = (f32x4){0.f, 0.f, 0.f, 0.f};
    bf16x8 At[4][2], B0[2][2], B1[2][2];
    unsigned vo[2][2], nvo[2][2];
    PG8_LOADVO(vo, cur);
    const char* cA = S.a_ptr(cur); const char* cB = S.b_ptr(cur);
    LAS unsigned char* const metab = lds + 8 * HTB;
    cur.meta = metab;
    if constexpr (Sched::META != 0) S.meta_issue(cur, metab, wid, lane);
    PG8_STAGE(PG8_SB(0, 0), cB, voffB); PG8_STAGE(PG8_SB(0, 1), cB + hstep, voffB); PG8_STAGE(PG8_SA(0, 0), cA, vo[0]); PG8_STAGE(PG8_SA(0, 1), cA, vo[1]);
    if (wr == 1) PG8_BAR;
    PG8_WAIT_V(2); PG8_BAR;
    PG8_STAGE(PG8_SB(1, 0), cB + kstep, voffB); PG8_STAGE(PG8_SA(1, 0), cA + kstep, vo[0]); PG8_STAGE(PG8_SB(1, 1), cB + hstep + kstep, voffB);
    if constexpr (ALLR) { PG8_STAGE(PG8_SA(1, 1), cA + kstep, vo[1]); PG8_WAIT_V(8); PG8_BAR; E.dummy(lane); }
    else { PG8_WAIT_V(6); PG8_BAR; }
    for (;;) {
        const bool has_next = S.next(ui + 1, nxt);
        const char* nA = cA; const char* nB = cB;
        if (has_next) { nA = S.a_ptr(nxt); nB = S.b_ptr(nxt); nxt.meta = metab + ((ui + 1) % 3) * 2048;
            if constexpr (Sched::META != 0) S.meta_issue(nxt, (LAS unsigned char*)nxt.meta, wid, lane);
            else if constexpr (Sched::GATHER) { PG8_LOADVO(nvo, nxt); } }
        const int segT = nt / SEGN;
#pragma nounroll
        for (int t = 0; t < nt; t += 2) {
            const bool last = (t == nt - 2);
            const char* a1 = cA + (size_t)(t + 1) * kstep;
            const char* a2 = last ? nA : cA + (size_t)(t + 2) * kstep; const char* b2 = last ? nB : cB + (size_t)(t + 2) * kstep;
            bool seg_start = false;
            if constexpr (SEGN > 1) {
                const int s1 = ALLR ? (t >> 1) : t / segT, s2 = ALLR ? s1 + 1 : (t + 2) / segT; seg_start = ALLR ? (t > 0) : (t > 0) && (t == s1 * segT);
                a1 = S.a_seg(cur, s1) + (size_t)(t + 1 - s1 * segT) * kstep;
                if (seg_start) { if ((HOIST || ALLR) && Epi::MIDSTORE) PG8_STAGE(PG8_SA(1, 1), a1, vo[1]); E.mid(acc, cur, s1 - 1, wr, wc, fr, fq); if constexpr (ALLR) PG8_SCHED; }
                if (!last) { a2 = S.a_seg(cur, s2) + (size_t)(t + 2 - s2 * segT) * kstep; b2 = S.b_seg(cur, s2) + (size_t)(t + 2 - s2 * segT) * kstep; }
            }
            const char* a3 = a2 + kstep; const char* b3 = b2 + kstep;
            bool relax = ALLR || ((t == 0) && (ui > 0));
            if constexpr (SEGN > 1) { if (Epi::MIDSTORE && seg_start) relax = true; }
            PG8_LDB(B0, 0, 0); PG8_LDB(B1, 0, 1); PG8_SCHED; PG8_LDA(At, 0, 0); if (!ALLR && !(HOIST && relax)) PG8_STAGE(PG8_SA(1, 1), a1, vo[1]);
            if constexpr (Sched::GATHER) { if (last && has_next) {
#pragma unroll
                for (int _h = 0; _h < 2; ++_h)
#pragma unroll
                    for (int _i = 0; _i < 2; ++_i) { if constexpr (Sched::META != 0) { int R2_, C2_; int tid2_ = threadIdx.x; asm volatile("" : "+v"(tid2_)); stage_rc(tid2_ * 16 + _i * 8192, R2_, C2_);
                            vo[_h][_i] = S.meta_off(nxt.meta, _h * HALF + R2_) + (unsigned)C2_ * 2u; } else vo[_h][_i] = nvo[_h][_i]; } } }
            PG8_WAIT_VR(relax); PG8_WAIT_L(0); PG8_BAR; PG8_MMA(0, 0, At, B0); PG8_MMA(0, 1, At, B1); PG8_BAR; PG8_SCHED;
            PG8_LDA(At, 0, 1); PG8_STAGE(PG8_SB(0, 0), b2, voffB); PG8_STAGE(PG8_SB(0, 1), b2 + hstep, voffB); PG8_STAGE(PG8_SA(0, 0), a2, vo[0]);
            PG8_WAIT_VR(relax); PG8_WAIT_L(0); PG8_BAR; PG8_MMA(1, 0, At, B0); PG8_MMA(1, 1, At, B1); PG8_BAR; PG8_SCHED;
            PG8_LDB(B0, 1, 0); PG8_LDB(B1, 1, 1); PG8_SCHED; PG8_LDA(At, 1, 0); PG8_STAGE(PG8_SA(0, 1), a2, vo[1]);
            PG8_WAIT_VR(ALLR || (HOIST && relax)); PG8_WAIT_L(0); PG8_BAR; PG8_MMA(0, 0, At, B0); PG8_MMA(0, 1, At, B1); PG8_BAR; PG8_SCHED;
            PG8_LDA(At, 1, 1); PG8_STAGE(PG8_SB(1, 0), b3, voffB); PG8_STAGE(PG8_SB(1, 1), b3 + hstep, voffB); PG8_STAGE(PG8_SA(1, 0), a3, vo[0]);
            PG8_WAIT_V(8); PG8_WAIT_L(0); PG8_BAR; PG8_MMA(1, 0, At, B0); PG8_MMA(1, 1, At, B1); PG8_BAR; PG8_SCHED;
        }
        if (HOIST || ALLR) PG8_STAGE(PG8_SA(1, 1), nA + kstep, vo[1]);
        if constexpr (ALIGN_EPI) { if (wr == 0) PG8_BAR; }
        E(acc, cur, wr, wc, fr, fq);
        if (!has_next) break;
#pragma unroll
        for (int a = 0; a < 2; ++a)
#pragma unroll
            for (int b = 0; b < 2; ++b)
#pragma unroll
                for (int m = 0; m < 4; ++m)
#pragma unroll
                    for (int n = 0; n < 2; ++n) acc[a][b][m][n] = (f32x4){0.f, 0.f, 0.f, 0.f};
        cur = nxt; cA = nA; cB = nB; ++ui;
        if constexpr (ALIGN_EPI) { if (wr == 1) PG8_BAR; }
    }
    PG8_WAIT_V(0);
    if constexpr (!ALIGN_EPI) { if (wr == 0) PG8_BAR; }
    PG8_BAR;
#undef PG8_SA
#undef PG8_SB
#undef PG8_STAGE
#undef PG8_LDA
#undef PG8_LDB
#undef PG8_MMA
#undef PG8_WAIT_V
#undef PG8_WAIT_VR
#undef PG8_WAIT_L
#undef PG8_BAR
#undef PG8_SCHED
#undef PG8_LOADVO
}

struct DenseSched {
    static constexpr bool GATHER = false; static constexpr int META = 0;
    const char* A; const char* Bt; const char* A2; const char* Bt2; int K; int nM, nN, nwg, G, c, i_lo, i_hi, nseg;
    __device__ __forceinline__ void init(const void* A_, const void* Bt_, int M, int N, int K_, int G_, int c_) { A = (const char*)A_; Bt = (const char*)Bt_; K = K_; nM = M / BM; nN = N / BM; nwg = nM * nN; G = G_; c = c_; i_lo = 0; i_hi = 1 << 30; nseg = 0; }
    __device__ __forceinline__ bool next(int i, Unit& u) const {
        i += i_lo; if (i >= i_hi) return false;
        const long L = (long)i * G + c; if (L >= nwg) return false;
        int wgid = (int)L; { const int q = nwg / NXCD, r = nwg % NXCD, xcd = wgid % NXCD, off = wgid / NXCD; wgid = (xcd < r ? xcd * (q + 1) : r * (q + 1) + (xcd - r) * q) + off; }
        const int nig = WGM * nN, gid = wgid / nig, fm = gid * WGM, gsz = (nM - fm) < WGM ? (nM - fm) : WGM;
        u.pm = fm + ((wgid % nig) % gsz); u.pn = (wgid % nig) / gsz; u.e = 0; return true;
    }
    __device__ __forceinline__ const char* a_ptr(const Unit& u) const { return A + (size_t)u.pm * BM * K * 2; }
    __device__ __forceinline__ const char* b_ptr(const Unit& u) const { return Bt + (size_t)u.pn * (nseg > 0 ? nseg : 1) * BM * K * 2; }
    __device__ __forceinline__ const char* a_seg(const Unit& u, int s) const { return ((nseg == 0 && s) ? A2 : A) + (size_t)u.pm * BM * K * 2; }
    __device__ __forceinline__ const char* b_seg(const Unit& u, int s) const { return nseg == 0 ? (s ? Bt2 : Bt) + (size_t)u.pn * BM * K * 2 : Bt + (size_t)(u.pn * nseg + s) * BM * K * 2; }
    __device__ __forceinline__ unsigned a_off(const Unit&, int row) const { return (unsigned)(row * K) * 2u; }
};
}

__device__ __forceinline__ void tr_item(const float* W, int K, int N, bf16* WT, int k0, int n0, int rb, LAS float* scr, int lane) {
#pragma unroll 8
    for (int i = 0; i < 32; ++i) { const int kk = 2 * i + (lane >> 5); scr[kk * 33 + (lane & 31)] = W[(size_t)(k0 + kk) * N + n0 + (lane & 31)]; }
    LDS_WAIT(); asm volatile("" ::: "memory");
    const int c = lane & 7;
#pragma unroll
    for (int j = 0; j < 4; ++j) { const int n = (lane >> 3) + 8 * j; const LAS float* s = scr + (8 * c) * 33 + n;
        u32x4 o; o.x = pk2(s[0 * 33], s[1 * 33]); o.y = pk2(s[2 * 33], s[3 * 33]); o.z = pk2(s[4 * 33], s[5 * 33]); o.w = pk2(s[6 * 33], s[7 * 33]);
        *(u32x4*)(WT + (size_t)(rb + n) * K + k0 + 8 * c) = o; }
    LDS_WAIT(); asm volatile("" ::: "memory");
}
__device__ __forceinline__ void tr_dense(const float* W, int K, int N, bf16* WT, int item, LAS float* scr, int lane) {
    const int nblk = N / 32, kb = item / nblk, nb = item % nblk;
    tr_item(W, K, N, WT, 64 * kb, 32 * nb, 32 * nb, scr, lane);
}
__device__ __forceinline__ void tr_expert(const Ctx& F, int e, int r, LAS float* scr) {
    const float* wg = (e < NE) ? F.in(16) + (size_t)e * DM * EDIM : F.in(19);
    const float* wu = (e < NE) ? F.in(17) + (size_t)e * DM * EDIM : F.in(20);
    const float* wd = (e < NE) ? F.in(18) + (size_t)e * EDIM * DM : F.in(21);
    bf16* gu = (bf16*)(F.ws + WS_WGU) + (size_t)e * 512 * 1024;
    bf16* dd = (bf16*)(F.ws + WS_WD) + (size_t)e * 1024 * 256;
    if (r < 256) {
        const int up = r >> 7, it = r & 127, kb = it >> 3, nb = it & 7, n0 = 32 * nb;
        const int rb = (n0 >> 7) * 256 + up * 128 + (n0 & 127);
        tr_item(up ? wu : wg, DM, EDIM, gu, 64 * kb, n0, rb, scr, F.lane);
    } else {
        const int it = r - 256, kb = it >> 5, nb = it & 31;
        tr_item(wd, EDIM, DM, dd, 64 * kb, 32 * nb, 32 * nb, scr, F.lane);
    }
}

constexpr int N_GU_ITEMS = 257 * 128, N_D_ITEMS = 257 * 64;
constexpr int CVT_GB = CVT_STAGGER ? 0 : 5 * 2048, CVT_G1 = CVT_STAGGER ? N_GU_ITEMS : CVT_GB + 8 * 2048, CVT_DB = 4 * 2048;
struct CvtItem { const float* W; bf16* WT; int N, K, k0, n0, rb; };
struct CvtBases { const float *g, *u, *d, *gs, *us, *ds; };
__device__ __forceinline__ CvtBases cvt_bases(const Ctx& F) { CvtBases b; b.g = F.in(16); b.u = F.in(17); b.d = F.in(18); b.gs = F.in(19); b.us = F.in(20); b.ds = F.in(21); return b; }
template <bool GU> __device__ __forceinline__ CvtItem cvt_decode(const Ctx& F, const CvtBases& P, int item) {
    CvtItem c;
    if (GU) {
        const int e = item / 128, r = item % 128;
        const int up = r >> 6, kb = (r & 63) >> 2, nb = r & 3, n0 = 64 * nb;
        c.W = up ? ((e < NE) ? P.u + (size_t)e * DM * EDIM : P.us) : ((e < NE) ? P.g + (size_t)e * DM * EDIM : P.gs);
        c.WT = MOE1_FP8 ? (bf16*)((unsigned char*)(F.ws + WS_WGU) + (size_t)e * 512 * 1024) : (bf16*)(F.ws + WS_WGU) + (size_t)e * 512 * 1024;
        c.N = EDIM; c.K = DM; c.k0 = 64 * kb; c.n0 = n0; c.rb = (n0 >> 7) * 256 + up * 128 + (n0 & 127);
    } else {
        const int e = item / 64, it = item % 64, kb = it >> 4, nb = it & 15;
        c.W = (e < NE) ? P.d + (size_t)e * EDIM * DM : P.ds; c.WT = MOE2_FP8 ? (bf16*)((unsigned char*)(F.ws + WS_WD) + (size_t)e * 1024 * 256) : (bf16*)(F.ws + WS_WD) + (size_t)e * 1024 * 256; c.N = DM; c.K = EDIM; c.k0 = 64 * kb; c.n0 = 64 * nb; c.rb = 64 * nb;
    }
    return c;
}
template <bool NT = true, bool F8 = false> __device__ __forceinline__ void cvt_load(const CvtItem& c, f32x4 (&v)[16], int lane) {
    const float* p = c.W + (size_t)(c.k0 + (F8 ? 2 : 1) * (lane >> 4)) * c.N + c.n0 + 4 * (lane & 15);
#pragma unroll
    for (int i = 0; i < 16; ++i) { const int ro = F8 ? 8 * (i >> 1) + (i & 1) : 4 * i; v[i] = NT ? __builtin_nontemporal_load((const f32x4*)(p + (size_t)ro * c.N)) : *(const f32x4*)(p + (size_t)ro * c.N); }
}
template <bool NT = true> __device__ __forceinline__ void cvt_store_f8(const CvtItem& c, const f32x4 (&v)[16], LAS unsigned char* img, int lane) {
    const int kp = lane >> 4, n4 = 4 * (lane & 15);
    LAS unsigned char* wp = img + (n4 >> 5) * 2048 + kp * 64 + (n4 & 31) * 2;
#pragma unroll
    for (int i = 0; i < 8; ++i) { const f32x4 a = v[2 * i] * W8_SCALE, b = v[2 * i + 1] * W8_SCALE; int t0 = 0, t1 = 0;
        t0 = __builtin_amdgcn_cvt_pk_fp8_f32(a.x, b.x, t0, false); t0 = __builtin_amdgcn_cvt_pk_fp8_f32(a.y, b.y, t0, true);
        t1 = __builtin_amdgcn_cvt_pk_fp8_f32(a.z, b.z, t1, false); t1 = __builtin_amdgcn_cvt_pk_fp8_f32(a.w, b.w, t1, true);
        *(LAS u32x2*)(wp + i * 256) = (u32x2){(unsigned)t0, (unsigned)t1}; }
    LDS_WAIT(); asm volatile("" ::: "memory");
    const int g = lane >> 4, q = (lane & 15) >> 2, p = lane & 3, i16 = lane & 15;
    unsigned char* wt = (unsigned char*)c.WT;
#pragma unroll
    for (int s = 0; s < 4; ++s) {
        const LAS unsigned char* rp = img + (s >> 1) * 2048 + (8 * g + q) * 64 + (16 * (s & 1) + 4 * p) * 2;
        const s16x4 lo = vtr(rp), hh = vtr(rp + 256);
        const u32x4 o = __builtin_bit_cast(u32x4, (bf16x8){lo[0], lo[1], lo[2], lo[3], hh[0], hh[1], hh[2], hh[3]});
        if (NT) __builtin_nontemporal_store(o, (u32x4*)(wt + (size_t)(c.rb + 16 * s + i16) * c.K + c.k0 + 16 * g)); else *(u32x4*)(wt + (size_t)(c.rb + 16 * s + i16) * c.K + c.k0 + 16 * g) = o;
    }
    LDS_WAIT(); asm volatile("" ::: "memory");
}
template <bool NT = true> __device__ __forceinline__ void cvt_store(const CvtItem& c, const f32x4 (&v)[16], LAS unsigned char* img, int lane) {
    const int kk0 = lane >> 4, n4 = 4 * (lane & 15);
    LAS unsigned char* wp = img + (n4 >> 5) * 4096 + kk0 * 64 + (n4 & 31) * 2;
#pragma unroll
    for (int i = 0; i < 16; ++i) { u32x2 w; w.x = pk2(v[i].x, v[i].y); w.y = pk2(v[i].z, v[i].w); *(LAS u32x2*)(wp + i * 256) = w; }
    LDS_WAIT(); asm volatile("" ::: "memory");
    const int g = lane >> 4, q = (lane & 15) >> 2, p = lane & 3, i16 = lane & 15;
#pragma unroll
    for (int s = 0; s < 8; ++s) {
        const int oct = 4 * (s & 1) + g, cb = s >> 1;
        const LAS unsigned char* rp = img + (cb >> 1) * 4096 + (8 * oct + q) * 64 + (16 * (cb & 1) + 4 * p) * 2;
        const s16x4 lo = vtr(rp), hh = vtr(rp + 256);
        u32x4 o = __builtin_bit_cast(u32x4, (bf16x8){lo[0], lo[1], lo[2], lo[3], hh[0], hh[1], hh[2], hh[3]});
        if (NT) __builtin_nontemporal_store(o, (u32x4*)(c.WT + (size_t)(c.rb + 16 * cb + i16) * c.K + c.k0 + 8 * oct)); else *(u32x4*)(c.WT + (size_t)(c.rb + 16 * cb + i16) * c.K + c.k0 + 8 * oct) = o;
    }
    LDS_WAIT(); asm volatile("" ::: "memory");
}
template <bool GU> __device__ __forceinline__ void cvt_experts_from1(const Ctx& F, LAS unsigned char* img, int it, const int NGW, const int item_hi) {
    constexpr bool F8 = GU ? (bool)MOE1_FP8 : (bool)MOE2_FP8;
    if (it >= item_hi) return;
    if (it + NGW >= item_hi) {
        f32x4 v1[16]; const CvtBases P1 = cvt_bases(F); const CvtItem c1 = cvt_decode<GU>(F, P1, it); cvt_load<true, F8>(c1, v1, F.lane);
        if (F8) cvt_store_f8(c1, v1, img, F.lane); else cvt_store(c1, v1, img, F.lane);
        return;
    }
    f32x4 va[16], vb[16];
    const CvtBases P = cvt_bases(F);
    CvtItem ca = cvt_decode<GU>(F, P, it), cb;
    cvt_load<true, F8>(ca, va, F.lane);
#if CVT_DEPTH == 3
    if (F8) {
        f32x4 vc[16]; CvtItem cc;
        { const int i1 = it + NGW, i1c = i1 < item_hi ? i1 : it; cb = cvt_decode<GU>(F, P, i1c); cvt_load<true, F8>(cb, vb, F.lane); }
        for (;;) {
            { const int i2 = it + 2 * NGW, i2c = i2 < item_hi ? i2 : it; cc = cvt_decode<GU>(F, P, i2c); cvt_load<true, F8>(cc, vc, F.lane); }
            cvt_store_f8(ca, va, img, F.lane);
            if (it + NGW >= item_hi) break;
            { const int i3 = it + 3 * NGW, i3c = i3 < item_hi ? i3 : it; ca = cvt_decode<GU>(F, P, i3c); cvt_load<true, F8>(ca, va, F.lane); }
            cvt_store_f8(cb, vb, img, F.lane);
            if (it + 2 * NGW >= item_hi) break;
            { const int i4 = it + 4 * NGW, i4c = i4 < item_hi ? i4 : it; cb = cvt_decode<GU>(F, P, i4c); cvt_load<true, F8>(cb, vb, F.lane); }
            cvt_store_f8(cc, vc, img, F.lane);
            if (it + 3 * NGW >= item_hi) break;
            it += 3 * NGW;
        }
        return;
    }
#endif
    for (;;) {
        const int it1 = it + NGW, it1c = it1 < item_hi ? it1 : it;
        cb = cvt_decode<GU>(F, P, it1c); cvt_load<true, F8>(cb, vb, F.lane);
        if (F8) cvt_store_f8(ca, va, img, F.lane); else cvt_store(ca, va, img, F.lane);
        if (it1 >= item_hi) break;
        const int it2 = it1 + NGW, it2c = it2 < item_hi ? it2 : it1;
        ca = cvt_decode<GU>(F, P, it2c); cvt_load<true, F8>(ca, va, F.lane);
        if (F8) cvt_store_f8(cb, vb, img, F.lane); else cvt_store(cb, vb, img, F.lane);
        if (it2 >= item_hi) break;
        it = it2;
    }
}
#ifndef CVT_REP
#define CVT_REP 1
#ifndef PROBE_ATT
#define PROBE_ATT 0
#endif
#ifndef CVT_DEPTH
#define CVT_DEPTH 2
#endif
#endif
template <bool GU> __device__ __forceinline__ void cvt_experts_from(const Ctx& F, LAS unsigned char* img, int it, const int NGW, const int item_hi) {
    if (CVT_REP == 1) cvt_experts_from1<GU>(F, img, it, NGW, item_hi);
    else {
#pragma nounroll
        for (int rep = 0; rep < CVT_REP; ++rep) { int r = rep; asm volatile("" : "+s"(r)); cvt_experts_from1<GU>(F, img, it + 0 * r, NGW, item_hi); }
    }
}
template <bool GU> __device__ __forceinline__ void cvt_experts(const Ctx& F, LAS unsigned char* img, const int item_lo, const int item_hi) {
    cvt_experts_from<GU>(F, img, item_lo + F.blk * NWAVES + F.wave, F.G * NWAVES, item_hi);
}
__device__ __forceinline__ void phase_prologue(const Ctx& F) { const float* const p_c = F.in(1); const float* const p_wada = F.in(2); const float* const p_bada = F.in(3); const float* const p_win = F.in(6); const float* const p_wba = F.in(9); const float* const p_wbb = F.in(10); const float* const p_wout = F.in(11); const float* const p_wr = F.in(14);
    {
        LAS float* sc = (LAS float*)(F.lds + 69632);
        LAS float* red = (LAS float*)(F.lds);
        float* mod = (float*)(F.ws + WS_MOD);
        for (int it = F.blk; it < 96; it += F.G) {
            __syncthreads();
            for (int i = F.tid; i < 16 * 1024; i += NTHR) { const float v = p_c[i]; sc[i] = v * sigmoidf_(v); }
            __syncthreads();
            const int col = it * 64 + F.lane, kb = F.wave * 128;
            float acc[16];
#pragma unroll
            for (int b = 0; b < 16; ++b) acc[b] = 0.f;
            for (int k = 0; k < 128; k += 4) {
                float w0 = p_wada[(size_t)(kb + k) * 6144 + col], w1 = p_wada[(size_t)(kb + k + 1) * 6144 + col], w2 = p_wada[(size_t)(kb + k + 2) * 6144 + col], w3 = p_wada[(size_t)(kb + k + 3) * 6144 + col];
#pragma unroll
                for (int b = 0; b < 16; ++b) { const f32x4 s = *(const LAS f32x4*)(sc + b * 1024 + kb + k); acc[b] += s.x * w0 + s.y * w1 + s.z * w2 + s.w * w3; }
            }
#pragma unroll
            for (int b = 0; b < 16; ++b) red[(F.wave * 16 + b) * 64 + F.lane] = acc[b];
            __syncthreads();
            for (int o = F.tid; o < 1024; o += NTHR) { const int b = o >> 6, l = o & 63; float s = 0.f;
#pragma unroll
                for (int w = 0; w < 8; ++w) s += red[(w * 16 + b) * 64 + l];
                mod[b * 6144 + it * 64 + l] = s + p_bada[it * 64 + l]; }
        }
        __syncthreads();
    }
    const int gw = F.blk * NWAVES + F.wave, NGW = F.G * NWAVES;
    constexpr int D_IN = 16 * 68, D_A = 8 * 16, D_OUT = 16 * 16, D_R = 16 * 4;
    constexpr int NDENSE = D_IN + 2 * D_A + D_OUT + D_R;
    for (int it = gw; it < NDENSE; it += NGW) {
        int r = it; CvtItem c;
        if (r < D_IN) { c.W = p_win; c.WT = (bf16*)(F.ws + WS_WIN); c.N = INW; c.K = DM; c.k0 = 64 * (r / 68); c.n0 = 64 * (r % 68); }
        else if ((r -= D_IN) < D_A) { c.W = p_wba; c.WT = (bf16*)(F.ws + WS_WA); c.N = DM; c.K = 512; c.k0 = 64 * (r / 16); c.n0 = 64 * (r % 16); }
        else if ((r -= D_A) < D_A) { c.W = p_wbb; c.WT = (bf16*)(F.ws + WS_WB); c.N = DM; c.K = 512; c.k0 = 64 * (r / 16); c.n0 = 64 * (r % 16); }
        else if ((r -= D_A) < D_OUT) { c.W = p_wout; c.WT = (bf16*)(F.ws + WS_WOUT); c.N = DM; c.K = DM; c.k0 = 64 * (r / 16); c.n0 = 64 * (r % 16); }
        else { r -= D_OUT; c.W = p_wr; c.WT = (bf16*)(F.ws + WS_WR); c.N = NE; c.K = DM; c.k0 = 64 * (r / 4); c.n0 = 64 * (r % 4); }
        c.rb = c.n0;
        const bool f8 = (F8G && it >= 16 * 36 && it < D_IN) || (F8B && it >= D_IN && it < D_IN + 2 * D_A) || (F8O && it >= D_IN + 2 * D_A && it < D_IN + 2 * D_A + D_OUT);
        if (F8G && it < D_IN) { c.k0 = 64 * (it % 16); c.n0 = 64 * (it / 16); c.rb = c.n0; if (f8) { c.WT = (bf16*)(F.ws + WS_WIN8); c.rb = c.n0 - C_GA; } }
        f32x4 v[16];
        if (f8) { cvt_load<false, true>(c, v, F.lane); cvt_store_f8<false>(c, v, F.lds + F.wave * 8448, F.lane); }
        else { cvt_load<false>(c, v, F.lane); cvt_store<false>(c, v, F.lds + F.wave * 8448, F.lane); }
    }
    if (NEW_CVT && CVT_IN_P0) { cvt_experts<true>(F, F.lds + F.wave * 8448, 0, N_GU_ITEMS); cvt_experts<false>(F, F.lds + F.wave * 8448, 0, N_D_ITEMS); }
    if (PROBE_CVT32 == 1 && ((F.blk >> 3) & 7) == 0) cvt_experts_from<true>(F, F.lds + F.wave * 8448, F.blk * NWAVES + F.wave, 2048, 8 * 2048);
    if (PROBE_CVT32 == 2) cvt_experts_from<true>(F, F.lds + F.wave * 8448, F.blk * NWAVES + F.wave, 2048, 8 * 2048);
}

__device__ __forceinline__ void phase_h(const Ctx& F) { const float* const p_x = F.in(0); const float* const p_gpm = F.in(4);
    const int gw = F.blk * NWAVES + F.wave, NGW = F.G * NWAVES;
    const float* mod = (const float*)(F.ws + WS_MOD);
    bf16* h = (bf16*)(F.ws + WS_A1);
    for (int ch = gw; ch < T / 16; ch += NGW) {
        const int row0 = ch * 16, b = row0 / SEQ;
        f32x4 gs[4], sh[4];
#pragma unroll
        for (int j = 0; j < 4; ++j) { const int col = 4 * F.lane + 256 * j;
            const f32x4 g = *(const f32x4*)(p_gpm + col), s1 = *(const f32x4*)(mod + b * 6144 + 1024 + col);
            gs[j] = g * (s1 + 1.0f); sh[j] = *(const f32x4*)(mod + b * 6144 + col); }
        for (int rr = 0; rr < 16; ++rr) {
            const float* xr = p_x + (size_t)(row0 + rr) * DM;
            f32x4 v[4]; float s = 0.f;
#pragma unroll
            for (int j = 0; j < 4; ++j) { v[j] = *(const f32x4*)(xr + 4 * F.lane + 256 * j); s += (v[j].x * v[j].x + v[j].y * v[j].y) + (v[j].z * v[j].z + v[j].w * v[j].w); }
            const float rinv = 1.0f / sqrtf(wave_sum(s) * (1.f / DM) + RMS_EPS);
            bf16* orow = h + (size_t)(row0 + rr) * DM;
#pragma unroll
            for (int j = 0; j < 4; ++j) { const f32x4 o = v[j] * rinv * gs[j] + sh[j]; u32x2 w; w.x = pk2(o.x, o.y); w.y = pk2(o.z, o.w); *(u32x2*)(orow + 4 * F.lane + 256 * j) = w;
                if (F8G) { int t8 = 0; t8 = __builtin_amdgcn_cvt_pk_fp8_f32(o.x, o.y, t8, false); t8 = __builtin_amdgcn_cvt_pk_fp8_f32(o.z, o.w, t8, true); *(unsigned*)(F.ws + WS_A3 + (size_t)(row0 + rr) * DM + 4 * F.lane + 256 * j) = (unsigned)t8; } }
        }
    }
}

template <int MODE> __device__ __forceinline__ void phase_dense(const Ctx& F) {
    const bf16* A; const bf16* Bt; int K, N;
    if (MODE == 0) { A = (const bf16*)(F.ws + WS_A1); Bt = (const bf16*)(F.ws + WS_WIN); K = 1024; N = INW; }
    else if (MODE == 1) { A = (const bf16*)(F.ws + WS_A2); Bt = (const bf16*)(F.ws + WS_WA); K = 512; N = 1024; }
    else if (MODE == 2) { A = (const bf16*)(F.ws + WS_A2) + (size_t)T * 512; Bt = (const bf16*)(F.ws + WS_WB); K = 512; N = 1024; }
    else if (MODE == 3) { A = (const bf16*)(F.ws + WS_A3); Bt = (const bf16*)(F.ws + WS_WOUT); K = 1024; N = 1024; }
    else { A = (const bf16*)(F.ws + WS_A2); Bt = (const bf16*)(F.ws + WS_WR); K = 1024; N = 256; }
    const int nN = N / 256, nU = (T / 128) * nN;
    const int r32 = F.lane & 31, hi = F.lane >> 5, wm = F.wave >> 2, wn = F.wave & 3;
    const int prow = F.tid >> 3, pch = F.tid & 7;
    bf16* proj = (bf16*)(F.ws + WS_PROJ);
    for (int u = F.blk; u < nU; u += F.G) {
        const int pm = u / nN, pn = u % nN;
        const char* pa0 = (const char*)(A + (size_t)(pm * 128 + prow) * K) + pch * 16;
        const char* pa1 = pa0 + (size_t)64 * K * 2;
        const char* pb0 = (const char*)(Bt + (size_t)(pn * 256 + prow) * K) + pch * 16;
        const size_t bs = (size_t)64 * K * 2;
        f32x16 acc[2][2];
        sg_mainloop(F.lds, pa0, pa1, pb0, pb0 + bs, pb0 + 2 * bs, pb0 + 3 * bs, K, acc);
#pragma unroll
        for (int mt = 0; mt < 2; ++mt) {
            const size_t row = (size_t)pm * 128 + wm * 64 + mt * 32 + r32;
#pragma unroll
            for (int j = 0; j < 2; ++j)
#pragma unroll
                for (int rg = 0; rg < 4; ++rg) {
                    const int col = pn * 256 + j * 128 + wn * 32 + 8 * rg + 4 * hi;
                    float v0 = acc[mt][j][4 * rg], v1 = acc[mt][j][4 * rg + 1], v2 = acc[mt][j][4 * rg + 2], v3 = acc[mt][j][4 * rg + 3];
                    if (MODE == 0) { u32x2 w; w.x = pk2(v0, v1); w.y = pk2(v2, v3); *(u32x2*)(proj + row * PLD + col) = w; }
                    else if (MODE == 1 || MODE == 2) {
                        const u32x2 g = *(const u32x2*)(proj + row * PLD + (MODE == 1 ? C_GA : C_GB) + col);
                        v0 *= sigmoidf_(bflo(g.x)); v1 *= sigmoidf_(bfhi(g.x)); v2 *= sigmoidf_(bflo(g.y)); v3 *= sigmoidf_(bfhi(g.y));
                        bf16* mp = (bf16*)(F.ws + WS_A3) + row * DM + col;
                        if (MODE == 2) { const u32x2 m = *(const u32x2*)mp; v0 += bflo(m.x); v1 += bfhi(m.x); v2 += bflo(m.y); v3 += bfhi(m.y); }
                        u32x2 w; w.x = pk2(v0, v1); w.y = pk2(v2, v3); *(u32x2*)mp = w;
                    } else if (MODE == 3) { u32x2 w; w.x = pk2(v0, v1); w.y = pk2(v2, v3); *(u32x2*)((bf16*)(F.ws + WS_A1) + row * DM + col) = w; }
                    else { *(f32x4*)((float*)(F.ws + WS_A1) + row * NE + col) = (f32x4){v0, v1, v2, v3}; }
                }
        }
    }
}


namespace pg8 {
struct EpiStoreBf16 {
    static constexpr int PERM = 1, NSTORE = 16; bf16* O; int ldc; int coff; float scale;
    __device__ __forceinline__ void operator()(const f32x4 (&acc)[2][2][4][2], const Unit& u, int wr, int wc, int fr, int fq) const {
        const int row0 = u.pm * BM + wr * 64 + fr, col0 = coff + u.pn * BM + wc * 32 + 8 * fq;
#pragma unroll
        for (int ai = 0; ai < 2; ++ai)
#pragma unroll
            for (int m = 0; m < 4; ++m) { bf16* rowp = O + (size_t)(row0 + ai * HALF + m * 16) * ldc + col0;
#pragma unroll
                for (int bj = 0; bj < 2; ++bj) { const f32x4 v0 = acc[ai][bj][m][0] * scale, v1 = acc[ai][bj][m][1] * scale;
                    u32x4 w; w.x = cvt_pk_bf16(v0[0], v0[1]); w.y = cvt_pk_bf16(v0[2], v0[3]); w.z = cvt_pk_bf16(v1[0], v1[1]); w.w = cvt_pk_bf16(v1[2], v1[3]);
                    *(u32x4*)(rowp + bj * HALF) = w; } }
    }
};
struct EpiStoreBf16W {
    static constexpr int PERM = 3, NSTORE = 16; static constexpr bool MIDSTORE = true, ALLTRIPS = false;
    bf16* O; int ldc; int coff; float scale; int ntile;
    __device__ __forceinline__ void store(const f32x4 (&acc)[2][2][4][2], const Unit& u, int s, int wr, int wc, int fr, int fq) const {
        const int odd = fr & 1;
        int row0 = u.pm * BM + wr * 64 + fr; const int col0 = coff + (u.pn * ntile + s) * BM + wc * 64 + 8 * fq + 32 * odd;
        asm volatile("" : "+v"(row0));
#pragma unroll
        for (int ai = 0; ai < 2; ++ai)
#pragma unroll
            for (int m = 0; m < 4; ++m) {
                u32x4 w[2];
#pragma unroll
                for (int bj = 0; bj < 2; ++bj) { const f32x4 v0 = acc[ai][bj][m][0] * scale, v1 = acc[ai][bj][m][1] * scale;
                    w[bj].x = cvt_pk_bf16(v0[0], v0[1]); w[bj].y = cvt_pk_bf16(v0[2], v0[3]); w[bj].z = cvt_pk_bf16(v1[0], v1[1]); w[bj].w = cvt_pk_bf16(v1[2], v1[3]); }
                const u32x4 snd = odd ? w[0] : w[1]; u32x4 rcv;
#pragma unroll
                for (int q = 0; q < 4; ++q) rcv[q] = (unsigned)__builtin_amdgcn_update_dpp(0, (int)snd[q], 0xB1  , 0xF, 0xF, false);
                const u32x4 A = odd ? rcv : w[0], B = odd ? w[1] : rcv;
                bf16* base = O + (size_t)(row0 - odd + ai * HALF + m * 16) * ldc + col0;
                if (EPI_NT) { __builtin_nontemporal_store(A, (u32x4*)base); __builtin_nontemporal_store(B, (u32x4*)(base + ldc)); } else { *(u32x4*)base = A; *(u32x4*)(base + ldc) = B; } }
    }
    __device__ __forceinline__ void mid(f32x4 (&acc)[2][2][4][2], const Unit& u, int s, int wr, int wc, int fr, int fq) const {
        store(acc, u, s, wr, wc, fr, fq);
#pragma unroll
        for (int a = 0; a < 2; ++a)
#pragma unroll
            for (int b = 0; b < 2; ++b)
#pragma unroll
                for (int m = 0; m < 4; ++m)
#pragma unroll
                    for (int n = 0; n < 2; ++n) acc[a][b][m][n] = (f32x4){0.f, 0.f, 0.f, 0.f};
    }
    __device__ __forceinline__ void operator()(const f32x4 (&acc)[2][2][4][2], const Unit& u, int wr, int wc, int fr, int fq) const { store(acc, u, ntile - 1, wr, wc, fr, fq); }
};
template <bool ADD> struct EpiGate {
    static constexpr int PERM = 1, NSTORE = 16; const bf16* proj; int gcol; bf16* merged; float scale; unsigned char* m8;
    __device__ __forceinline__ void operator()(const f32x4 (&acc)[2][2][4][2], const Unit& u, int wr, int wc, int fr, int fq) const {
        const int row0 = u.pm * BM + wr * 64 + fr, col0 = u.pn * BM + wc * 32 + 8 * fq;
#pragma unroll
        for (int ai = 0; ai < 2; ++ai)
#pragma unroll
            for (int m = 0; m < 4; ++m) { const size_t row = (size_t)(row0 + ai * HALF + m * 16);
#pragma unroll
                for (int bj = 0; bj < 2; ++bj) { f32x4 v0 = acc[ai][bj][m][0] * scale, v1 = acc[ai][bj][m][1] * scale;
                    const u32x4 g = *(const u32x4*)(proj + row * PLD + gcol + col0 + bj * HALF);
                    v0[0] *= sigmoidf_(bflo(g.x)); v0[1] *= sigmoidf_(bfhi(g.x)); v0[2] *= sigmoidf_(bflo(g.y)); v0[3] *= sigmoidf_(bfhi(g.y));
                    v1[0] *= sigmoidf_(bflo(g.z)); v1[1] *= sigmoidf_(bfhi(g.z)); v1[2] *= sigmoidf_(bflo(g.w)); v1[3] *= sigmoidf_(bfhi(g.w));
                    bf16* mp = merged + row * DM + col0 + bj * HALF;
                    if (ADD) { const u32x4 o = *(const u32x4*)mp; v0[0] += bflo(o.x); v0[1] += bfhi(o.x); v0[2] += bflo(o.y); v0[3] += bfhi(o.y); v1[0] += bflo(o.z); v1[1] += bfhi(o.z); v1[2] += bflo(o.w); v1[3] += bfhi(o.w); }
                    if (ADD && F8O) { v0 = v0 * MRG8_SCALE; v1 = v1 * MRG8_SCALE; int t0 = 0, t1 = 0;
                        t0 = __builtin_amdgcn_cvt_pk_fp8_f32(v0[0], v0[1], t0, false); t0 = __builtin_amdgcn_cvt_pk_fp8_f32(v0[2], v0[3], t0, true);
                        t1 = __builtin_amdgcn_cvt_pk_fp8_f32(v1[0], v1[1], t1, false); t1 = __builtin_amdgcn_cvt_pk_fp8_f32(v1[2], v1[3], t1, true);
                        *(u32x2*)(m8 + row * DM + col0 + bj * HALF) = (u32x2){(unsigned)t0, (unsigned)t1}; }
                    else { u32x4 w; w.x = cvt_pk_bf16(v0[0], v0[1]); w.y = cvt_pk_bf16(v0[2], v0[3]); w.z = cvt_pk_bf16(v1[0], v1[1]); w.w = cvt_pk_bf16(v1[2], v1[3]);
                        *(u32x4*)mp = w; } } }
    }
};
struct EpiBranch {
    static constexpr int PERM = 1, NSTORE = 16; static constexpr bool MIDSTORE = false, ALLTRIPS = false; const bf16* proj; bf16* merged;
    __device__ __forceinline__ void mid(f32x4 (&acc)[2][2][4][2], const Unit& u, int, int wr, int wc, int fr, int fq) const {
        int row0 = u.pm * BM + wr * 64 + fr; const int col0 = u.pn * BM + wc * 32 + 8 * fq;
        asm volatile("" : "+v"(row0));
#pragma unroll
        for (int ai = 0; ai < 2; ++ai) {
            u32x4 ga[4][2], gb[4][2];
#pragma unroll
            for (int m = 0; m < 4; ++m)
#pragma unroll
                for (int bj = 0; bj < 2; ++bj) { const bf16* gp = proj + (size_t)(row0 + ai * HALF + m * 16) * PLD + col0 + bj * HALF; ga[m][bj] = *(const u32x4*)(gp + C_GA); gb[m][bj] = *(const u32x4*)(gp + C_GB); }
#pragma unroll
            for (int m = 0; m < 4; ++m)
#pragma unroll
                for (int bj = 0; bj < 2; ++bj)
#pragma unroll
                    for (int q = 0; q < 4; ++q) { const unsigned wa = ga[m][bj][q], wb = gb[m][bj][q];
                        const float r0 = (1.0f + ex2(-fmaxf(bflo(wb), -60.f) * LOG2E)) * __builtin_amdgcn_rcpf(1.0f + ex2(-bflo(wa) * LOG2E)), r1 = (1.0f + ex2(-fmaxf(bfhi(wb), -60.f) * LOG2E)) * __builtin_amdgcn_rcpf(1.0f + ex2(-bfhi(wa) * LOG2E));
                        acc[ai][bj][m][q >> 1][2 * (q & 1)] *= r0; acc[ai][bj][m][q >> 1][2 * (q & 1) + 1] *= r1; }
            asm volatile("" ::: "memory");
        }
    }
    __device__ __forceinline__ void operator()(const f32x4 (&acc)[2][2][4][2], const Unit& u, int wr, int wc, int fr, int fq) const {
        int row0 = u.pm * BM + wr * 64 + fr; const int col0 = u.pn * BM + wc * 32 + 8 * fq;
        asm volatile("" : "+v"(row0));
#pragma unroll
        for (int ai = 0; ai < 2; ++ai)
#pragma unroll
            for (int m = 0; m < 4; ++m) { const size_t row = (size_t)(row0 + ai * HALF + m * 16);
#pragma unroll
                for (int bj = 0; bj < 2; ++bj) { f32x4 v0 = acc[ai][bj][m][0], v1 = acc[ai][bj][m][1];
                    const u32x4 g = *(const u32x4*)(proj + row * PLD + C_GB + col0 + bj * HALF);
#define SGC(x) sigmoidf_(fmaxf((x), -60.f))
                    v0[0] *= SGC(bflo(g.x)); v0[1] *= SGC(bfhi(g.x)); v0[2] *= SGC(bflo(g.y)); v0[3] *= SGC(bfhi(g.y));
                    v1[0] *= SGC(bflo(g.z)); v1[1] *= SGC(bfhi(g.z)); v1[2] *= SGC(bflo(g.w)); v1[3] *= SGC(bfhi(g.w));
#undef SGC
                    u32x4 w; w.x = cvt_pk_bf16(v0[0], v0[1]); w.y = cvt_pk_bf16(v0[2], v0[3]); w.z = cvt_pk_bf16(v1[0], v1[1]); w.w = cvt_pk_bf16(v1[2], v1[3]);
                    *(u32x4*)(merged + row * DM + col0 + bj * HALF) = w; } }
    }
};
struct EpiF32 {
    static constexpr int PERM = 0, NSTORE = 32; float* C; int ldc;
    __device__ __forceinline__ void operator()(const f32x4 (&acc)[2][2][4][2], const Unit& u, int wr, int wc, int fr, int fq) const {
        const int row0 = u.pm * BM + wr * 64 + fr, col0 = u.pn * BM + wc * 32 + 4 * fq;
#pragma unroll
        for (int ai = 0; ai < 2; ++ai)
#pragma unroll
            for (int m = 0; m < 4; ++m) { float* rowp = C + (size_t)(row0 + ai * HALF + m * 16) * ldc + col0;
#pragma unroll
                for (int bj = 0; bj < 2; ++bj)
#pragma unroll
                    for (int n = 0; n < 2; ++n) *(f32x4*)(rowp + bj * HALF + n * 16) = acc[ai][bj][m][n]; }
    }
};
template <int STAGE> struct MoeSched {
    static constexpr bool GATHER = (STAGE == 1); static constexpr int META = STAGE;
    static constexpr bool F8 = (STAGE == 1) ? (bool)MOE1_FP8 : (bool)MOE2_FP8;
    static constexpr bool PAIR = (STAGE == 2) && MOE2_PAIR;
    static constexpr int NPN = (STAGE == 1) ? 2 : (PAIR ? 2 : 4), K = (STAGE == 1) ? (F8 ? 512 : 1024) : (F8 ? 128 : 256);
    const int* tile_e; const int* tokp; const int* ypos; const float* wpad; const char* Abase; const char* Bbase; int nrt, nU, G, c;
    __device__ __forceinline__ void meta_issue(const Unit& u, LAS unsigned char* slot, int wid, int lane_) const {
        int lane; asm volatile("v_mbcnt_lo_u32_b32 %0, -1, 0\n\tv_mbcnt_hi_u32_b32 %0, -1, %0" : "=v"(lane));
        if (STAGE == 1) { if (wid == 0) __builtin_amdgcn_global_load_lds((const unsigned*)(tokp + u.pm * BM + 4 * lane), (LAS unsigned*)slot, 16, 0, 0); }
        else { if (wid == 0) __builtin_amdgcn_global_load_lds((const unsigned*)(ypos + u.pm * BM + 4 * lane), (LAS unsigned*)slot, 16, 0, 0);
               if (wid == 1) __builtin_amdgcn_global_load_lds((const unsigned*)(wpad + u.pm * BM + 4 * lane), (LAS unsigned*)(slot + 1024), 16, 0, 0); }
    }
    __device__ __forceinline__ unsigned meta_off(const LAS unsigned char* slot, int row) const { int tk = ((const LAS int*)slot)[row]; tk = tk < 0 ? 0 : tk; return (unsigned)tk * (unsigned)(K * 2); }
    __device__ __forceinline__ bool next(int i, Unit& u) const {
        const long L = (long)i * G + c; if (L >= nU) return false;
        int id = (int)L; { const int q = nU / NXCD, r = nU % NXCD, xcd = id % NXCD, off = id / NXCD; id = (xcd < r ? xcd * (q + 1) : r * (q + 1) + (xcd - r) * q) + off; }
        const int tq = id / NPN; u.pn = id % NPN; u.pm = tq < nrt ? tq : SH_TILE0 + (tq - nrt); { int ev; const int* tp = tile_e + u.pm; asm volatile("s_load_dword %0, %1, 0x0\n\ts_waitcnt lgkmcnt(0)" : "=s"(ev) : "s"(tp) : "memory"); u.e = ev; } return true;
    }
    __device__ __forceinline__ const char* a_ptr(const Unit& u) const { return STAGE == 1 ? Abase : Abase + (size_t)u.pm * BM * K * 2; }
    __device__ __forceinline__ const char* b_ptr(const Unit& u) const { return Bbase + ((size_t)u.e * ((PAIR ? 4 : NPN) * BM) + (size_t)u.pn * (PAIR ? 2 : 1) * BM) * K * 2; }
    __device__ __forceinline__ const char* a_seg(const Unit& u, int) const { return a_ptr(u); }
    __device__ __forceinline__ const char* b_seg(const Unit& u, int s) const { return b_ptr(u) + (size_t)s * BM * K * 2; }
    __device__ __forceinline__ unsigned a_off(const Unit& u, int row) const {
        if (STAGE == 1) { int tk = tokp[u.pm * BM + row]; tk = tk < 0 ? 0 : tk; return (unsigned)tk * (unsigned)(K * 2); }
        return (unsigned)(row * K) * 2u;
    }
};
struct EpiHid {
    static constexpr int PERM = 1, NSTORE = 8; static constexpr float unscale = MOE1_FP8 ? 1.0f / W8_SCALE : 1.0f; bf16* hid;
    __device__ __forceinline__ void operator()(const f32x4 (&acc)[2][2][4][2], const Unit& u, int wr, int wc, int fr, int fq) const {
        const int row0 = u.pm * BM + wr * 64 + fr, col0 = u.pn * HALF + wc * 32 + 8 * fq;
#pragma unroll
        for (int ai = 0; ai < 2; ++ai)
#pragma unroll
            for (int m = 0; m < 4; ++m) { float hv[8];
#pragma unroll
                for (int n = 0; n < 2; ++n)
#pragma unroll
                    for (int q = 0; q < 4; ++q) { const float gt = acc[ai][0][m][n][q] * unscale, up = acc[ai][1][m][n][q] * unscale; hv[4 * n + q] = gt * sigmoidf_(gt) * up; }
                if (MOE2_FP8) { int t0 = 0, t1 = 0;
                    t0 = __builtin_amdgcn_cvt_pk_fp8_f32(clamp8(hv[0] * HID8_SCALE), clamp8(hv[1] * HID8_SCALE), t0, false); t0 = __builtin_amdgcn_cvt_pk_fp8_f32(clamp8(hv[2] * HID8_SCALE), clamp8(hv[3] * HID8_SCALE), t0, true);
                    t1 = __builtin_amdgcn_cvt_pk_fp8_f32(clamp8(hv[4] * HID8_SCALE), clamp8(hv[5] * HID8_SCALE), t1, false); t1 = __builtin_amdgcn_cvt_pk_fp8_f32(clamp8(hv[6] * HID8_SCALE), clamp8(hv[7] * HID8_SCALE), t1, true);
                    *(u32x2*)((unsigned char*)hid + (size_t)(row0 + ai * HALF + m * 16) * EDIM + col0) = (u32x2){(unsigned)t0, (unsigned)t1}; }
                else { u32x4 w; w.x = cvt_pk_bf16(hv[0], hv[1]); w.y = cvt_pk_bf16(hv[2], hv[3]); w.z = cvt_pk_bf16(hv[4], hv[5]); w.w = cvt_pk_bf16(hv[6], hv[7]);
                    *(u32x4*)(hid + (size_t)(row0 + ai * HALF + m * 16) * EDIM + col0) = w; } }
    }
};
struct EpiY {
    static constexpr int PERM = 2, NSTORE = 8; static constexpr bool MIDSTORE = true, ALLTRIPS = (bool)MOE2_PAIR; unsigned char* Y; int var;
    __device__ __forceinline__ void dummy(int lane) const {
        const unsigned char* q = Y + (size_t)(NASSIGN + T) * DM; const unsigned o = (unsigned)lane * 16u; const u32x4 z = (u32x4){0u, 0u, 0u, 0u};
#pragma unroll
        for (int i = 0; i < NSTORE; ++i) asm volatile("global_store_dwordx4 %0, %1, %2" :: "v"(o), "v"(z), "s"(q) : "memory");
    }
    __device__ __forceinline__ void store(const f32x4 (&acc)[2][2][4][2], const Unit& u, int pn, int wr, int wc, int fr, int fq) const {
        const int col0 = pn * BM + wc * 64 + 16 * fq;
#pragma unroll
        for (int ai = 0; ai < 2; ++ai)
#pragma unroll
            for (int m = 0; m < 4; ++m) { const int rl = wr * 64 + fr + ai * HALF + m * 16;
                const int yp = ((const LAS int*)u.meta)[rl]; const float wv = ((const LAS float*)(u.meta + 1024))[rl] * (MOE2_FP8 ? Y8_SCALE / (W8_SCALE * HID8_SCALE) : Y8_SCALE);
                size_t yrow = yp >= 0 ? (size_t)yp : (size_t)(NASSIGN + T); u32x4 w;
                if (PROBE_MOE2 && var == 2) yrow &= 4095;
#pragma unroll
                for (int bj = 0; bj < 2; ++bj)
#pragma unroll
                    for (int n = 0; n < 2; ++n) { const f32x4 v = acc[ai][bj][m][n] * wv; int t = 0;
                        t = __builtin_amdgcn_cvt_pk_fp8_f32(clamp8(v[0]), clamp8(v[1]), t, false); t = __builtin_amdgcn_cvt_pk_fp8_f32(clamp8(v[2]), clamp8(v[3]), t, true); w[2 * bj + n] = (unsigned)t; }
                if (!(PROBE_MOE2 && var == 3)) *(u32x4*)(Y + yrow * DM + col0) = w; }
    }
    __device__ __forceinline__ void mid(f32x4 (&acc)[2][2][4][2], const Unit& u, int, int wr, int wc, int fr, int fq) const {
        store(acc, u, 2 * u.pn, wr, wc, fr, fq);
#pragma unroll
        for (int a = 0; a < 2; ++a)
#pragma unroll
            for (int b = 0; b < 2; ++b)
#pragma unroll
                for (int m = 0; m < 4; ++m)
#pragma unroll
                    for (int n = 0; n < 2; ++n) acc[a][b][m][n] = (f32x4){0.f, 0.f, 0.f, 0.f};
    }
    __device__ __forceinline__ void operator()(const f32x4 (&acc)[2][2][4][2], const Unit& u, int wr, int wc, int fr, int fq) const {
        store(acc, u, MOE2_PAIR ? 2 * u.pn + 1 : u.pn, wr, wc, fr, fq);
    }
};
}

__device__ __forceinline__ void cvt_p2(const Ctx& F) {
    constexpr int SPLIT = CVT_GB + P2_CVT_HI * 1024;
    if (F.G == 256) { if (F.blk >= 128) cvt_experts_from<true>(F, F.lds + F.wave * 8448, CVT_GB + (F.blk - 128) * NWAVES + F.wave, 1024, SPLIT);
                      else cvt_experts_from<true>(F, F.lds + F.wave * 8448, SPLIT + F.blk * NWAVES + F.wave, 1024, CVT_G1); }
    else cvt_experts<true>(F, F.lds + F.wave * 8448, CVT_GB, CVT_G1);
}
template <int MODE> __device__ __forceinline__ void phase_dense_fast(const Ctx& F) {
    pg8::DenseSched S; constexpr bool F8 = (MODE == 1 || MODE == 2) ? (bool)F8B : (MODE == 3) ? (bool)F8O : false;
    if (MODE == 0) {
        const int grp = (F.blk >> 3) & 7;
        if (SPREAD_D9 + SPREAD_D8A + SPREAD_D8B > 0 && F.G == 256) {
            const unsigned ticks = F.blk < 128 ? (unsigned)(F.blk * SPREAD_D9 * 100) / 128u : (unsigned)(SPREAD_D8A * 100) + (unsigned)((F.blk - 128) * SPREAD_D8B * 100) / 128u;
            const unsigned long long t0 = __builtin_amdgcn_s_memrealtime(); while (__builtin_amdgcn_s_memrealtime() - t0 < (unsigned long long)ticks) __builtin_amdgcn_s_sleep(4); }
        if (INPROJ_LATE_US > 0 && F.G == 256 && F.blk >= 128) {
            const unsigned long long t0 = __builtin_amdgcn_s_memrealtime(); while (__builtin_amdgcn_s_memrealtime() - t0 < (unsigned long long)(INPROJ_LATE_US * 100)) __builtin_amdgcn_s_sleep(8); }
        pg8::EpiStoreBf16W E{(bf16*)(F.ws + WS_PROJ), PLD, 0, 1.0f, 1};
        if (INPROJ_QUAD && !F8G) {
            const bool spreadq = NEW_CVT && !CVT_IN_P0; const int g4 = grp & 3;
            pg8::DenseSched Sq; Sq.init(F.ws + WS_A1, F.ws + WS_WIN, T, 4 * 256, 1024, F.G, F.blk); Sq.nseg = 4;
            pg8::EpiStoreBf16W Eq{(bf16*)(F.ws + WS_PROJ), PLD, 0, 1.0f, 4};
            int Kq = 4096; asm volatile("" : "+s"(Kq));
            if (spreadq && g4 == 0) { cvt_p2(F); __syncthreads(); }
            Sq.i_lo = 0; Sq.i_hi = (spreadq && g4 == 1) ? 1 : (1 << 30); pg8::gemm_phase<pg8::EpiStoreBf16W, pg8::DenseSched, true, false, 4>(F.lds, Kq, Sq, Eq);
            if (spreadq && g4 == 1) { cvt_p2(F); __syncthreads(); Sq.i_lo = 1; Sq.i_hi = 1 << 30; pg8::gemm_phase<pg8::EpiStoreBf16W, pg8::DenseSched, true, false, 4>(F.lds, Kq, Sq, Eq); }
            if (spreadq && g4 == 2) { cvt_p2(F); __syncthreads(); }
            pg8::DenseSched Ss; Ss.init(F.ws + WS_A1, F.ws + WS_WIN + (size_t)16 * 256 * 1024 * 2, T, 256, 1024, F.G, F.blk);
            pg8::EpiStoreBf16W Es{(bf16*)(F.ws + WS_PROJ), PLD, 16 * 256, 1.0f, 1};
            pg8::gemm_phase<pg8::EpiStoreBf16W, pg8::DenseSched, true>(F.lds, 1024, Ss, Es);
            if (spreadq && g4 == 3) { cvt_p2(F); __syncthreads(); }
            return;
        }
        S.init(F.ws + WS_A1, F.ws + WS_WIN, T, F8G ? C_GA : INW, 1024, F.G, F.blk);
        const bool spread = NEW_CVT && !CVT_IN_P0;
        const int split = !spread ? 0 : F8G ? (grp < 2 ? 0 : grp < 4 ? 2 : 1 << 30) : grp;
        S.i_lo = 0; S.i_hi = split; pg8::gemm_phase<pg8::EpiStoreBf16W, pg8::DenseSched, true>(F.lds, 1024, S, E);
        if (spread && (!F8G || grp < 4)) { cvt_p2(F); __syncthreads(); }
        S.i_lo = split; S.i_hi = 1 << 30; pg8::gemm_phase<pg8::EpiStoreBf16W, pg8::DenseSched, true>(F.lds, 1024, S, E);
        if (F8G) {
            pg8::DenseSched S8; S8.init(F.ws + WS_A3, F.ws + WS_WIN8, T, INW - C_GA, 512, F.G, F.blk);
            pg8::EpiStoreBf16 E8{(bf16*)(F.ws + WS_PROJ), PLD, C_GA, 1.0f / W8_SCALE};
            const int split8 = !spread ? 0 : (grp < 6 ? 0 : 2);
            if (spread && grp >= 4 && grp < 6) { cvt_p2(F); __syncthreads(); }
            S8.i_lo = 0; S8.i_hi = split8; pg8::gemm_phase<pg8::EpiStoreBf16, pg8::DenseSched, true, true>(F.lds, 512, S8, E8);
            if (spread && grp >= 6) { cvt_p2(F); __syncthreads(); }
            S8.i_lo = split8; S8.i_hi = 1 << 30; pg8::gemm_phase<pg8::EpiStoreBf16, pg8::DenseSched, true, true>(F.lds, 512, S8, E8);
        }
    }
    else if (MODE == 1 && FUSE_BR) {
        S.init(F.ws + WS_A2, F.ws + WS_WA, T, DM, 512, F.G, F.blk); S.A2 = (const char*)(F.ws + WS_A2 + (size_t)T * 1024); S.Bt2 = (const char*)(F.ws + WS_WB);
        pg8::EpiBranch E{(const bf16*)(F.ws + WS_PROJ), (bf16*)(F.ws + WS_A3)};
        int Kk = 1024; asm volatile("" : "+s"(Kk));
        pg8::gemm_phase<pg8::EpiBranch, pg8::DenseSched, true, false, 2>(F.lds, Kk, S, E); }
    else if (MODE == 2 && FUSE_BR) { }
    else if (MODE == 1) { S.init(F.ws + WS_A2, F.ws + WS_WA, T, DM, F8 ? 256 : 512, F.G, F.blk); pg8::EpiGate<false> E{(const bf16*)(F.ws + WS_PROJ), C_GA, (bf16*)(F.ws + WS_A3), F8 ? 1.0f / (W8_SCALE * ATT8_SCALE) : 1.0f, nullptr};
        pg8::gemm_phase<pg8::EpiGate<false>, pg8::DenseSched, true, F8>(F.lds, F8 ? 256 : 512, S, E); }
    else if (MODE == 2) { S.init(F.ws + WS_A2 + (size_t)T * (F8 ? 512 : 1024), F.ws + WS_WB, T, DM, F8 ? 256 : 512, F.G, F.blk);
        pg8::EpiGate<true> E{(const bf16*)(F.ws + WS_PROJ), C_GB, (bf16*)(F.ws + WS_A3), F8 ? 1.0f / (W8_SCALE * ATT8_SCALE) : 1.0f, (unsigned char*)(F.ws + WS_A1)};
        pg8::gemm_phase<pg8::EpiGate<true>, pg8::DenseSched, true, F8>(F.lds, F8 ? 256 : 512, S, E); }
    else if (MODE == 3) { S.init(F.ws + (F8 ? WS_A1 : WS_A3), F.ws + WS_WOUT, T, DM, F8 ? 512 : 1024, F.G, F.blk);
        pg8::EpiStoreBf16 E{(bf16*)(F.ws + (F8 ? WS_A3 : WS_A1)), DM, 0, F8 ? 1.0f / (W8_SCALE * MRG8_SCALE) : 1.0f};
        pg8::gemm_phase<pg8::EpiStoreBf16, pg8::DenseSched, true, F8>(F.lds, F8 ? 512 : 1024, S, E); }
    else { S.init(F.ws + WS_A2, F.ws + WS_WR, T, NE, 1024, F.G, F.blk); pg8::EpiF32 E{(float*)(F.ws + WS_A1), NE}; pg8::gemm_phase<pg8::EpiF32, pg8::DenseSched, true>(F.lds, 1024, S, E); }
}
template <int STAGE> __device__ __forceinline__ void phase_moe_fast(const Ctx& F) {
    const int nrt = (int)__hip_atomic_load((unsigned*)(F.ws + WS_CTL) + CW_NRT, __ATOMIC_RELAXED, __HIP_MEMORY_SCOPE_AGENT);
    pg8::MoeSched<STAGE> S;
    S.tile_e = (const int*)(F.ws + WS_TILEE); S.tokp = (const int*)(F.ws + WS_TOKP); S.ypos = (const int*)(F.ws + WS_YPOS); S.wpad = (const float*)(F.ws + WS_WPAD); S.nrt = nrt; S.nU = (nrt + T / 256) * pg8::MoeSched<STAGE>::NPN; S.G = F.G; S.c = F.blk;
    if (STAGE == 1) { S.Abase = (const char*)(F.ws + (MOE1_FP8 ? WS_H2F8 : WS_A2)); S.Bbase = (const char*)(F.ws + WS_WGU); pg8::EpiHid E{(bf16*)(F.ws + WS_A3)};
        pg8::gemm_phase<pg8::EpiHid, pg8::MoeSched<STAGE>, true, pg8::MoeSched<STAGE>::F8>(F.lds, pg8::MoeSched<STAGE>::K, S, E); }
    else { S.Abase = (const char*)(F.ws + WS_A3); S.Bbase = (const char*)(F.ws + WS_WD); pg8::EpiY E{(unsigned char*)(F.ws + WS_Y), PROBE_MOE2 ? F.karg_int(50) : 0};
        int Kk = pg8::MoeSched<STAGE>::K * (MOE2_PAIR ? 2 : 1); asm volatile("" : "+s"(Kk));
        pg8::gemm_phase<pg8::EpiY, pg8::MoeSched<STAGE>, false, pg8::MoeSched<STAGE>::F8, MOE2_PAIR ? 2 : 1>(F.lds, Kk, S, E); }
}

__device__ __forceinline__ unsigned cvtpk(float lo, float hi) { unsigned r; asm volatile("v_cvt_pk_bf16_f32 %0, %1, %2" : "=v"(r) : "v"(lo), "v"(hi)); return r; }
__device__ __forceinline__ void store_o_tile(const f32x16 (&o)[2], bf16* dst, LAS unsigned char* stg, int lane) {
    const int r32 = lane & 31, hi = lane >> 5;
    if (F8B) {
#pragma unroll
        for (int dt = 0; dt < 2; ++dt)
#pragma unroll
            for (int r = 0; r < 16; ++r) { const int t = __builtin_amdgcn_cvt_pk_fp8_f32(o[dt][r] * ATT8_SCALE, 0.f, 0, false); *(LAS unsigned char*)(stg + crow(r, hi) * 64 + 32 * dt + r32) = (unsigned char)t; }
        LDS_WAIT(); asm volatile("" ::: "memory");
#pragma unroll
        for (int i = 0; i < 2; ++i) { const int row = i * 16 + (lane >> 2), ch = lane & 3; *(u32x4*)((unsigned char*)dst + (size_t)row * 512 + ch * 16) = *(const LAS u32x4*)(stg + row * 64 + ch * 16); }
        LDS_WAIT(); asm volatile("" ::: "memory");
        return;
    }
#pragma unroll
    for (int dt = 0; dt < 2; ++dt)
#pragma unroll
        for (int r = 0; r < 16; ++r) *(LAS unsigned short*)(stg + crow(r, hi) * 128 + (32 * dt + r32) * 2) = (unsigned short)f2bf(o[dt][r]);
    LDS_WAIT(); asm volatile("" ::: "memory");
#pragma unroll
    for (int i = 0; i < 4; ++i) { const int row = i * 8 + (lane >> 3), ch = lane & 7; *(u32x4*)(dst + (size_t)row * 512 + ch * 8) = *(const LAS u32x4*)(stg + row * 128 + ch * 16); }
    LDS_WAIT(); asm volatile("" ::: "memory");
}
__device__ __forceinline__ void phase_swa(const Ctx& F) { const float* const p_sinks = F.in(7); const float* const p_relb = F.in(8);
    const bf16* proj = (const bf16*)(F.ws + WS_PROJ);
    bf16* ya = (bf16*)(F.ws + WS_A2);
    LAS unsigned char* Kl = F.lds;
    LAS unsigned char* Vl = F.lds + 24576;
    LAS float* biasL = (LAS float*)(F.lds + 49152);
    LAS unsigned char* stg = F.lds + 65536 + F.wave * 4096;
    const int r32 = F.lane & 31, hi = F.lane >> 5;
    __syncthreads();
    for (int i = F.tid; i < 8 * 384; i += NTHR) { const int hd = i / 384, ri = i % 384; biasL[i] = p_relb[(int)T5B[ri] * 8 + hd] * LOG2E; }
    constexpr int NU = NB * 32 * 2;
    const int g = F.wave >> 1, qh = F.wave & 1;
    const int skey = F.tid >> 3, sch = F.tid & 7;
    u32x4 kreg[3], vreg[3]; u32x4 qn[4];
#define SWA_DECODE(uu, hk_, c_, b_, nkc_, kstart_) const int hk_ = (uu) & 1, c_ = ((uu) >> 1) & 31, b_ = (uu) >> 6; const int nkc_ = (c_ < 2 ? c_ : 2) + 1, kstart_ = (c_ - nkc_ + 1) * 64
#define SWA_REQUEST(uu) do { SWA_DECODE(uu, hk_, c_, b_, nkc_, ks_); \
        _Pragma("unroll") for (int i = 0; i < 3; ++i) { const int key = skey + 64 * i; const int keyc = key < nkc_ * 64 ? key : 0; const bf16* s_ = proj + (size_t)(b_ * SEQ + ks_ + keyc) * PLD + hk_ * 64 + sch * 8; \
            kreg[i] = *(const u32x4*)(s_ + C_KA); vreg[i] = *(const u32x4*)(s_ + C_VA); } \
        _Pragma("unroll") for (int d0 = 0; d0 < 4; ++d0) qn[d0] = *(const u32x4*)(proj + (size_t)(b_ * SEQ + c_ * 64 + qh * 32 + r32) * PLD + C_QA + (hk_ * 4 + g) * 64 + d0 * 16 + hi * 8); } while (0)
    int u = (ATT_XCD && (F.G & 7) == 0) ? (F.blk & 7) * (F.G >> 3) + (F.blk >> 3) : F.blk;
    if (u < NU) SWA_REQUEST(u);
    for (; u < NU; u += F.G) {
        SWA_DECODE(u, hk, c, b, nkc, kstart); const int nk = nkc * 64, nkt = nkc * 2;
        __syncthreads();
#pragma unroll
        for (int i = 0; i < 3; ++i) { const int key = skey + 64 * i;
            if (key < nk) { *(LAS u32x4*)(Kl + sch * 3072 + key * 16) = kreg[i]; *(LAS u32x4*)(Vl + (sch >> 2) * 12288 + key * 64 + (sch & 3) * 16) = vreg[i]; } }
        bf16x8 qf[4];
#pragma unroll
        for (int d0 = 0; d0 < 4; ++d0) { const float sc = 0.125f * LOG2E; u32x4 qs; const u32x4 qv = qn[d0];
            qs.x = cvtpk(bflo(qv.x) * sc, bfhi(qv.x) * sc); qs.y = cvtpk(bflo(qv.y) * sc, bfhi(qv.y) * sc); qs.z = cvtpk(bflo(qv.z) * sc, bfhi(qv.z) * sc); qs.w = cvtpk(bflo(qv.w) * sc, bfhi(qv.w) * sc);
            qf[d0] = __builtin_bit_cast(bf16x8, qs); }
        __syncthreads();
        { const int un = (u + F.G < NU) ? u + F.G : u; SWA_REQUEST(un); }
        const int head = hk * 4 + g, qpos = c * 64 + qh * 32 + r32;
        f32x16 sc[6];
#pragma unroll
        for (int kt = 0; kt < 6; ++kt) {
            sc[kt] = (f32x16){0.f, 0.f, 0.f, 0.f, 0.f, 0.f, 0.f, 0.f, 0.f, 0.f, 0.f, 0.f, 0.f, 0.f, 0.f, 0.f};
            if (kt < nkt) {
#pragma unroll
                for (int d0 = 0; d0 < 4; ++d0) { const bf16x8 kf = *(const LAS bf16x8*)(Kl + (2 * d0 + hi) * 3072 + (32 * kt + r32) * 16);
                    sc[kt] = __builtin_amdgcn_mfma_f32_32x32x16_bf16(kf, qf[d0], sc[kt], 0, 0, 0); }
            }
        }
        const float sink2 = p_sinks[head] * LOG2E;
        float m = sink2;
        const LAS float* bl = biasL + head * 384 + 255 + (kstart - qpos);
#pragma unroll
        for (int kt = 0; kt < 6; ++kt) if (kt < nkt) {
#pragma unroll
            for (int r = 0; r < 16; ++r) { const float l2 = sc[kt][r] + bl[32 * kt + crow(r, hi)]; sc[kt][r] = l2; m = fmaxf(m, l2); }
        }
        m = fmaxf(m, __shfl_xor(m, 32));
        float sum = 0.f;
#pragma unroll
        for (int kt = 0; kt < 6; ++kt) if (kt < nkt) {
#pragma unroll
            for (int r = 0; r < 16; ++r) { const float p = ex2(sc[kt][r] - m); sc[kt][r] = p; sum += p; }
        }
        sum += __shfl_xor(sum, 32);
        const float inv = 1.0f / (sum + ex2(sink2 - m));
        f32x16 o[2];
        o[0] = (f32x16){0.f, 0.f, 0.f, 0.f, 0.f, 0.f, 0.f, 0.f, 0.f, 0.f, 0.f, 0.f, 0.f, 0.f, 0.f, 0.f}; o[1] = o[0];
        const int vlane = ((F.lane >> 4) & 1) * 32 + (F.lane & 3) * 8 + (4 * hi + ((F.lane & 15) >> 2)) * 64;
#pragma unroll
        for (int kt = 0; kt < 6; ++kt) if (kt < nkt) {
#pragma unroll
            for (int ks = 0; ks < 2; ++ks) {
                u32x4 pw; pw.x = cvtpk(sc[kt][8 * ks] * inv, sc[kt][8 * ks + 1] * inv); pw.y = cvtpk(sc[kt][8 * ks + 2] * inv, sc[kt][8 * ks + 3] * inv);
                pw.z = cvtpk(sc[kt][8 * ks + 4] * inv, sc[kt][8 * ks + 5] * inv); pw.w = cvtpk(sc[kt][8 * ks + 6] * inv, sc[kt][8 * ks + 7] * inv);
                const bf16x8 pa = __builtin_bit_cast(bf16x8, pw);
#pragma unroll
                for (int dt = 0; dt < 2; ++dt) {
                    const LAS unsigned char* vp = Vl + dt * 12288 + (32 * kt + 16 * ks) * 64 + vlane;
                    const s16x4 lo = vtr(vp), hh = vtr(vp + 512);
                    const bf16x8 vf = (bf16x8){lo[0], lo[1], lo[2], lo[3], hh[0], hh[1], hh[2], hh[3]};
                    o[dt] = __builtin_amdgcn_mfma_f32_32x32x16_bf16(pa, vf, o[dt], 0, 0, 0);
                }
            }
        }
        if (F8B) store_o_tile(o, (bf16*)((unsigned char*)ya + (size_t)(b * SEQ + c * 64 + qh * 32) * 512 + head * 64), stg, F.lane);
        else store_o_tile(o, ya + (size_t)(b * SEQ + c * 64 + qh * 32) * 512 + head * 64, stg, F.lane);
    }
#undef SWA_DECODE
#undef SWA_REQUEST
}

#if SB_V2
__device__ __forceinline__ void phase_sb(const Ctx& F) {
    const bf16* proj = (const bf16*)(F.ws + WS_PROJ);
    bf16* yb = (bf16*)(F.ws + WS_A2) + (size_t)T * 512;
    volatile LAS int* flags = (volatile LAS int*)(F.lds + 131072);
    const int r32 = F.lane & 31, hi = F.lane >> 5;
    const int vlane = ((F.lane >> 4) & 1) * 32 + (F.lane & 3) * 8 + (4 * hi + ((F.lane & 15) >> 2)) * 64;
    const int skey = F.tid >> 3, sch = F.tid & 7;
    const unsigned kw = sch * 1024 + skey * 16, vw = 8192 + (sch >> 2) * 4096 + skey * 64 + (sch & 3) * 16;
    const int wh = F.wave >> 1, wq = F.wave & 1;
    constexpr int NU = NB * 2 * 32;
    u32x4 ka[4], va[4], kb2[4], vb2[4], qn[4];
#define SB_DECODE(uu, qb_, hg_, b_) const int qb_ = ((uu) + ((uu) >> 5)) & 31, hg_ = ((uu) >> 5) & 1, b_ = (uu) >> 6
#define SB_REQUEST(uu) do { SB_DECODE(uu, qb_, hg_, b_); const bf16* src_ = proj + (size_t)(b_ * SEQ + skey) * PLD + hg_ * 256 + sch * 8; const int t1_ = qb_ >= 1 ? qb_ - 1 : 0; \
        _Pragma("unroll") for (int i = 0; i < 4; ++i) { ka[i] = *(const u32x4*)(src_ + (size_t)qb_ * 64 * PLD + C_KB + i * 64); va[i] = *(const u32x4*)(src_ + (size_t)qb_ * 64 * PLD + C_VB + i * 64); \
            kb2[i] = *(const u32x4*)(src_ + (size_t)t1_ * 64 * PLD + C_KB + i * 64); vb2[i] = *(const u32x4*)(src_ + (size_t)t1_ * 64 * PLD + C_VB + i * 64); } \
        _Pragma("unroll") for (int d0 = 0; d0 < 4; ++d0) qn[d0] = *(const u32x4*)(proj + (size_t)(b_ * SEQ + qb_ * 64 + wq * 32 + r32) * PLD + C_QB + (hg_ * 4 + wh) * 64 + d0 * 16 + hi * 8); } while (0)
    int u = (ATT_XCD && (F.G & 7) == 0) ? (F.blk & 7) * (F.G >> 3) + (F.blk >> 3) : F.blk;
    if (u < NU) SB_REQUEST(u);
    for (; u < NU; u += F.G) {
        SB_DECODE(u, qb, hg, b);
        const int q0 = qb * 64, qw = q0 + wq * 32, qpos = qw + r32, head = hg * 4 + wh;
        const int kt0 = qb;
        __syncthreads();
#pragma unroll
        for (int i = 0; i < 4; ++i) { *(LAS u32x4*)(F.lds + i * 16384 + kw) = ka[i]; *(LAS u32x4*)(F.lds + i * 16384 + vw) = va[i];
                                      *(LAS u32x4*)(F.lds + 65536 + i * 16384 + kw) = kb2[i]; *(LAS u32x4*)(F.lds + 65536 + i * 16384 + vw) = vb2[i]; }
        bf16x8 qf[4];
#pragma unroll
        for (int d0 = 0; d0 < 4; ++d0) {
            const u32x4 qv = qn[d0]; u32x4 qs; const float sc = 0.125f * LOG2E;
            qs.x = cvtpk(bflo(qv.x) * sc, bfhi(qv.x) * sc); qs.y = cvtpk(bflo(qv.y) * sc, bfhi(qv.y) * sc); qs.z = cvtpk(bflo(qv.z) * sc, bfhi(qv.z) * sc); qs.w = cvtpk(bflo(qv.w) * sc, bfhi(qv.w) * sc);
            qf[d0] = __builtin_bit_cast(bf16x8, qs); }
        { const int un = (u + F.G < NU) ? u + F.G : u; SB_REQUEST(un); }
        f32x16 o[2];
        o[0] = (f32x16){0.f, 0.f, 0.f, 0.f, 0.f, 0.f, 0.f, 0.f, 0.f, 0.f, 0.f, 0.f, 0.f, 0.f, 0.f, 0.f}; o[1] = o[0];
        float R = 1.f; bool mydone = false;
        __syncthreads();
        auto tile = [&](LAS unsigned char* Kl, const int kb, const bool diag) __attribute__((always_inline)) {
            LAS unsigned char* Vl = Kl + 8192;
            f32x16 p0 = (f32x16){0.f, 0.f, 0.f, 0.f, 0.f, 0.f, 0.f, 0.f, 0.f, 0.f, 0.f, 0.f, 0.f, 0.f, 0.f, 0.f}, p1 = p0;
#pragma unroll
            for (int d0 = 0; d0 < 4; ++d0) {
                const bf16x8 k0f = *(const LAS bf16x8*)(Kl + (2 * d0 + hi) * 1024 + r32 * 16), k1f = *(const LAS bf16x8*)(Kl + (2 * d0 + hi) * 1024 + (32 + r32) * 16);
                p0 = __builtin_amdgcn_mfma_f32_32x32x16_bf16(k0f, qf[d0], p0, 0, 0, 0);
                p1 = __builtin_amdgcn_mfma_f32_32x32x16_bf16(k1f, qf[d0], p1, 0, 0, 0);
            }
            float kp[32], lb[32];
#pragma unroll
            for (int e = 0; e < 32; ++e) {
                const float z2 = (e < 16 ? p0[e] : p1[e - 16]);
                const float uu = ex2(-fabsf(z2)), rr_ = __builtin_amdgcn_rcpf(1.0f + uu), ur = uu * rr_;
                const bool pos = z2 >= 0.f;
                lb[e] = pos ? rr_ : ur; kp[e] = pos ? ur : rr_;
            }
            if (diag) {
#pragma unroll
                for (int e = 0; e < 32; ++e) { const bool valid = (kb + 8 * (e >> 2) + 4 * hi + (e & 3)) < qpos; kp[e] = valid ? kp[e] : 1.f; lb[e] = valid ? lb[e] : 0.f; }
            }
            float A = R;
#pragma unroll
            for (int i = 7; i >= 0; --i) {
                const float gs = (kp[4 * i] * kp[4 * i + 1]) * (kp[4 * i + 2] * kp[4 * i + 3]);
                const auto rr = __builtin_amdgcn_permlane32_swap(__float_as_uint(gs), __float_as_uint(gs), false, false);
                const float g0 = __uint_as_float(rr[0]), g1 = __uint_as_float(rr[1]);
                const float c3 = A * (hi == 0 ? g1 : 1.f), c2 = c3 * kp[4 * i + 3], c1 = c2 * kp[4 * i + 2], c0 = c1 * kp[4 * i + 1];
                lb[4 * i + 3] *= c3; lb[4 * i + 2] *= c2; lb[4 * i + 1] *= c1; lb[4 * i] *= c0;
                A *= g0 * g1;
            }
            R = A;
#pragma unroll
            for (int k4 = 0; k4 < 4; ++k4) {
                u32x4 pw; pw.x = cvtpk(lb[8 * k4], lb[8 * k4 + 1]); pw.y = cvtpk(lb[8 * k4 + 2], lb[8 * k4 + 3]); pw.z = cvtpk(lb[8 * k4 + 4], lb[8 * k4 + 5]); pw.w = cvtpk(lb[8 * k4 + 6], lb[8 * k4 + 7]);
                const bf16x8 pa = __builtin_bit_cast(bf16x8, pw);
#pragma unroll
                for (int dt = 0; dt < 2; ++dt) {
                    const LAS unsigned char* vp = Vl + dt * 4096 + (16 * k4) * 64 + vlane;
                    const s16x4 lo = vtr(vp), hh = vtr(vp + 512);
                    const bf16x8 vf = (bf16x8){lo[0], lo[1], lo[2], lo[3], hh[0], hh[1], hh[2], hh[3]};
                    o[dt] = __builtin_amdgcn_mfma_f32_32x32x16_bf16(pa, vf, o[dt], 0, 0, 0);
                }
            }
            mydone = __all(R < 3.5e-15f);
        };
        tile(F.lds + wh * 16384, kt0 * 64, true);
        if (kt0 >= 1 && !mydone) tile(F.lds + 65536 + wh * 16384, (kt0 - 1) * 64, false);
        const bf16* kvsrc = proj + (size_t)(b * SEQ + skey) * PLD + hg * 256 + sch * 8;
#pragma nounroll
        for (int kt = kt0 - 2, it = 0; ; --kt, ++it) {
            if (F.lane == 0) flags[(it & 1) * 8 + F.wave] = mydone ? 1 : 0;
            __syncthreads();
            int alld = 1;
#pragma unroll
            for (int w = 0; w < 8; ++w) alld &= flags[(it & 1) * 8 + w];
            if (alld || kt < 0) break;
#pragma nounroll
            for (int i = 0; i < 4; ++i) { const u32x4 kx = *(const u32x4*)(kvsrc + (size_t)kt * 64 * PLD + C_KB + i * 64), vx = *(const u32x4*)(kvsrc + (size_t)kt * 64 * PLD + C_VB + i * 64);
                *(LAS u32x4*)(F.lds + i * 16384 + kw) = kx; *(LAS u32x4*)(F.lds + i * 16384 + vw) = vx; }
            __syncthreads();
            if (!mydone) tile(F.lds + wh * 16384, kt * 64, false);
        }
        if (F8B) store_o_tile(o, (bf16*)((unsigned char*)(F.ws + WS_A2) + (size_t)T * 512 + (size_t)(b * SEQ + qw) * 512 + head * 64), F.lds + F.wave * 4096, F.lane);
        else store_o_tile(o, yb + (size_t)(b * SEQ + qw) * 512 + head * 64, F.lds + F.wave * 4096, F.lane);
    }
#undef SB_DECODE
#undef SB_REQUEST
}
#else
__device__ __forceinline__ void phase_sb(const Ctx& F) {
    const bf16* proj = (const bf16*)(F.ws + WS_PROJ);
    bf16* yb = (bf16*)(F.ws + WS_A2) + (size_t)T * 512;
    volatile LAS int* flags = (volatile LAS int*)(F.lds + 131072);
    const int r32 = F.lane & 31, hi = F.lane >> 5;
    const int vlane = ((F.lane >> 4) & 1) * 32 + (F.lane & 3) * 8 + (4 * hi + ((F.lane & 15) >> 2)) * 64;
    const int skey = F.tid >> 3, sch = F.tid & 7;
    const unsigned kw = sch * 1024 + skey * 16, vw = 8192 + (sch >> 2) * 4096 + skey * 64 + (sch & 3) * 16;
    const int wh = F.wave >> 1, wq = F.wave & 1;
    for (int u = (ATT_XCD && (F.G & 7) == 0) ? (F.blk & 7) * (F.G >> 3) + (F.blk >> 3) : F.blk; u < NB * 2 * 32; u += F.G) {
        const int qb = (u + (u >> 5)) & 31, hg = (u >> 5) & 1, b = u >> 6;
        const int q0 = qb * 64, qw = q0 + wq * 32, qpos = qw + r32, head = hg * 4 + wh;
        const bf16* kvsrc = proj + (size_t)(b * SEQ + skey) * PLD + hg * 256 + sch * 8;
        const int kt0 = qb;
        __syncthreads();
        u32x4 kreg[4], vreg[4];
#pragma unroll
        for (int i = 0; i < 4; ++i) { kreg[i] = *(const u32x4*)(kvsrc + (size_t)kt0 * 64 * PLD + C_KB + i * 64); vreg[i] = *(const u32x4*)(kvsrc + (size_t)kt0 * 64 * PLD + C_VB + i * 64); }
        bf16x8 qf[4];
#pragma unroll
        for (int d0 = 0; d0 < 4; ++d0) {
            const u32x4 qv = *(const u32x4*)(proj + (size_t)(b * SEQ + qpos) * PLD + C_QB + head * 64 + d0 * 16 + hi * 8); u32x4 qs; const float sc = 0.125f * LOG2E;
            qs.x = cvtpk(bflo(qv.x) * sc, bfhi(qv.x) * sc); qs.y = cvtpk(bflo(qv.y) * sc, bfhi(qv.y) * sc); qs.z = cvtpk(bflo(qv.z) * sc, bfhi(qv.z) * sc); qs.w = cvtpk(bflo(qv.w) * sc, bfhi(qv.w) * sc);
            qf[d0] = __builtin_bit_cast(bf16x8, qs); }
#pragma unroll
        for (int i = 0; i < 4; ++i) { *(LAS u32x4*)(F.lds + i * 16384 + kw) = kreg[i]; *(LAS u32x4*)(F.lds + i * 16384 + vw) = vreg[i]; }
        if (kt0 >= 1) {
#pragma unroll
            for (int i = 0; i < 4; ++i) { kreg[i] = *(const u32x4*)(kvsrc + (size_t)(kt0 - 1) * 64 * PLD + C_KB + i * 64); vreg[i] = *(const u32x4*)(kvsrc + (size_t)(kt0 - 1) * 64 * PLD + C_VB + i * 64); } }
        f32x16 o[2];
        o[0] = (f32x16){0.f, 0.f, 0.f, 0.f, 0.f, 0.f, 0.f, 0.f, 0.f, 0.f, 0.f, 0.f, 0.f, 0.f, 0.f, 0.f}; o[1] = o[0];
        float R = 1.f; bool mydone = false;
        __syncthreads();
        for (int kt = kt0, it = 0; kt >= 0; --kt, ++it) {
            const int kb = kt * 64;
            LAS unsigned char* Kl = F.lds + (it & 1) * 65536 + wh * 16384; LAS unsigned char* Vl = Kl + 8192;
            if (!mydone) {
                f32x16 p0 = (f32x16){0.f, 0.f, 0.f, 0.f, 0.f, 0.f, 0.f, 0.f, 0.f, 0.f, 0.f, 0.f, 0.f, 0.f, 0.f, 0.f}, p1 = p0;
#pragma unroll
                for (int d0 = 0; d0 < 4; ++d0) {
                    const bf16x8 k0f = *(const LAS bf16x8*)(Kl + (2 * d0 + hi) * 1024 + r32 * 16), k1f = *(const LAS bf16x8*)(Kl + (2 * d0 + hi) * 1024 + (32 + r32) * 16);
                    p0 = __builtin_amdgcn_mfma_f32_32x32x16_bf16(k0f, qf[d0], p0, 0, 0, 0);
                    p1 = __builtin_amdgcn_mfma_f32_32x32x16_bf16(k1f, qf[d0], p1, 0, 0, 0);
                }
                float kp[32], lb[32];
                const bool diag = (kt == kt0);
#pragma unroll
                for (int e = 0; e < 32; ++e) {
                    const float z2 = (e < 16 ? p0[e] : p1[e - 16]);
                    const float uu = ex2(-fabsf(z2)), rr_ = __builtin_amdgcn_rcpf(1.0f + uu), ur = uu * rr_;
                    const bool pos = z2 >= 0.f;
                    lb[e] = pos ? rr_ : ur; kp[e] = pos ? ur : rr_;
                }
                if (diag) {
#pragma unroll
                    for (int e = 0; e < 32; ++e) { const bool valid = (kb + 8 * (e >> 2) + 4 * hi + (e & 3)) < qpos; kp[e] = valid ? kp[e] : 1.f; lb[e] = valid ? lb[e] : 0.f; }
                }
                float A = R;
#pragma unroll
                for (int i = 7; i >= 0; --i) {
                    const float gs = (kp[4 * i] * kp[4 * i + 1]) * (kp[4 * i + 2] * kp[4 * i + 3]);
                    const auto rr = __builtin_amdgcn_permlane32_swap(__float_as_uint(gs), __float_as_uint(gs), false, false);
                    const float g0 = __uint_as_float(rr[0]), g1 = __uint_as_float(rr[1]);
                    const float c3 = A * (hi == 0 ? g1 : 1.f), c2 = c3 * kp[4 * i + 3], c1 = c2 * kp[4 * i + 2], c0 = c1 * kp[4 * i + 1];
                    lb[4 * i + 3] *= c3; lb[4 * i + 2] *= c2; lb[4 * i + 1] *= c1; lb[4 * i] *= c0;
                    A *= g0 * g1;
                }
                R = A;
#pragma unroll
                for (int k4 = 0; k4 < 4; ++k4) {
                    u32x4 pw; pw.x = cvtpk(lb[8 * k4], lb[8 * k4 + 1]); pw.y = cvtpk(lb[8 * k4 + 2], lb[8 * k4 + 3]); pw.z = cvtpk(lb[8 * k4 + 4], lb[8 * k4 + 5]); pw.w = cvtpk(lb[8 * k4 + 6], lb[8 * k4 + 7]);
                    const bf16x8 pa = __builtin_bit_cast(bf16x8, pw);
#pragma unroll
                    for (int dt = 0; dt < 2; ++dt) {
                        const LAS unsigned char* vp = Vl + dt * 4096 + (16 * k4) * 64 + vlane;
                        const s16x4 lo = vtr(vp), hh = vtr(vp + 512);
                        const bf16x8 vf = (bf16x8){lo[0], lo[1], lo[2], lo[3], hh[0], hh[1], hh[2], hh[3]};
                        o[dt] = __builtin_amdgcn_mfma_f32_32x32x16_bf16(pa, vf, o[dt], 0, 0, 0);
                    }
                }
                mydone = __all(R < 3.5e-15f);
            }
            if (kt >= 1) { LAS unsigned char* nb = F.lds + ((it + 1) & 1) * 65536;
#pragma unroll
                for (int i = 0; i < 4; ++i) { *(LAS u32x4*)(nb + i * 16384 + kw) = kreg[i]; *(LAS u32x4*)(nb + i * 16384 + vw) = vreg[i]; } }
            if (kt >= 2) {
#pragma unroll
                for (int i = 0; i < 4; ++i) { kreg[i] = *(const u32x4*)(kvsrc + (size_t)(kt - 2) * 64 * PLD + C_KB + i * 64); vreg[i] = *(const u32x4*)(kvsrc + (size_t)(kt - 2) * 64 * PLD + C_VB + i * 64); } }
            if (F.lane == 0) flags[(it & 1) * 8 + F.wave] = mydone ? 1 : 0;
            __syncthreads();
            int alld = 1;
#pragma unroll
            for (int w = 0; w < 8; ++w) alld &= flags[(it & 1) * 8 + w];
            if (alld) break;
        }
        if (F8B) store_o_tile(o, (bf16*)((unsigned char*)(F.ws + WS_A2) + (size_t)T * 512 + (size_t)(b * SEQ + qw) * 512 + head * 64), F.lds + F.wave * 4096, F.lane);
        else store_o_tile(o, yb + (size_t)(b * SEQ + qw) * 512 + head * 64, F.lds + F.wave * 4096, F.lane);
    }
}

#endif

__device__ __forceinline__ void phase_mid(const Ctx& F) { const float* const p_x = F.in(0); const float* const p_gpost = F.in(5); const float* const p_gpre = F.in(12);
    const int gw = F.blk * NWAVES + F.wave, NGW = F.G * NWAVES;
    const float* mod = (const float*)(F.ws + WS_MOD);
    const bf16* o = (const bf16*)(F.ws + (F8O ? WS_A3 : WS_A1));
    bf16* h2 = (bf16*)(F.ws + WS_A2); bf16* xmid = (bf16*)(F.ws + WS_XMID);
    for (int ch = gw; ch < T / 16; ch += NGW) {
        const int row0 = ch * 16, b = row0 / SEQ;
        f32x4 gp[4], g2[4], s2[4];
#pragma unroll
        for (int j = 0; j < 4; ++j) { const int col = 4 * F.lane + 256 * j;
            gp[j] = *(const f32x4*)(p_gpost + col) * *(const f32x4*)(mod + b * 6144 + 2 * 1024 + col);
            g2[j] = *(const f32x4*)(p_gpre + col) * (*(const f32x4*)(mod + b * 6144 + 4 * 1024 + col) + 1.0f);
            s2[j] = *(const f32x4*)(mod + b * 6144 + 3 * 1024 + col); }
        for (int rr = 0; rr < 16; ++rr) {
            const size_t row = (size_t)(row0 + rr);
            f32x4 v[4], xv[4]; float s = 0.f;
#pragma unroll
            for (int j = 0; j < 4; ++j) { const u32x2 w = *(const u32x2*)(o + row * DM + 4 * F.lane + 256 * j);
                v[j] = (f32x4){bflo(w.x), bfhi(w.x), bflo(w.y), bfhi(w.y)}; xv[j] = *(const f32x4*)(p_x + row * DM + 4 * F.lane + 256 * j);
                s += (v[j].x * v[j].x + v[j].y * v[j].y) + (v[j].z * v[j].z + v[j].w * v[j].w); }
            const float r1 = 1.0f / sqrtf(wave_sum(s) * (1.f / DM) + RMS_EPS);
            float q = 0.f;
#pragma unroll
            for (int j = 0; j < 4; ++j) { xv[j] = xv[j] + v[j] * r1 * gp[j]; { u32x2 w; w.x = pk2(xv[j].x, xv[j].y); w.y = pk2(xv[j].z, xv[j].w); *(u32x2*)(xmid + row * DM + 4 * F.lane + 256 * j) = w; }
                q += (xv[j].x * xv[j].x + xv[j].y * xv[j].y) + (xv[j].z * xv[j].z + xv[j].w * xv[j].w); }
            const float r2 = 1.0f / sqrtf(wave_sum(q) * (1.f / DM) + RMS_EPS);
#pragma unroll
            for (int j = 0; j < 4; ++j) { const f32x4 hv = xv[j] * r2 * g2[j] + s2[j]; u32x2 w; w.x = pk2(hv.x, hv.y); w.y = pk2(hv.z, hv.w); *(u32x2*)(h2 + row * DM + 4 * F.lane + 256 * j) = w;
                if (MOE1_FP8) { int t8 = 0; t8 = __builtin_amdgcn_cvt_pk_fp8_f32(hv.x, hv.y, t8, false); t8 = __builtin_amdgcn_cvt_pk_fp8_f32(hv.z, hv.w, t8, true); *(unsigned*)(F.ws + WS_H2F8 + row * DM + 4 * F.lane + 256 * j) = (unsigned)t8; } }
        }
    }
}

__device__ __forceinline__ unsigned fkey(float v) { const unsigned k = __float_as_uint(v); return (k & 0x80000000u) ? ~k : (k | 0x80000000u); }
__device__ __forceinline__ int mbcnt64(unsigned long long b) { return (int)__builtin_amdgcn_mbcnt_hi((unsigned)(b >> 32), __builtin_amdgcn_mbcnt_lo((unsigned)b, 0u)); }
__device__ __forceinline__ void phase_route(const Ctx& F) { const float* const p_rb = F.in(15);
    const float* logits = (const float*)(F.ws + WS_A1);
    int* idxg = (int*)(F.ws + WS_IDX); float* wtg = (float*)(F.ws + WS_WT); int* rankg = (int*)(F.ws + WS_RANK);
    unsigned* bb = (unsigned*)(F.ws + WS_BB);
    unsigned* gcnt = (unsigned*)(F.ws + WS_CTL) + CW_GCNT;
    LAS int* hist = (LAS int*)(F.lds);
    __syncthreads();
    if (F.tid < NE) hist[F.tid] = 0;
    __syncthreads();
    const int tpb = (T + F.G - 1) / F.G, t0 = F.blk * tpb, t1 = (t0 + tpb < T) ? t0 + tpb : T;
    const f32x4 rb = *(const f32x4*)(p_rb + 4 * F.lane);
    for (int t = t0 + F.wave; t < t1; t += NWAVES) {
        const f32x4 lg = *(const f32x4*)(logits + (size_t)t * NE + 4 * F.lane);
        const float s0 = sigmoidf_(lg.x), s1 = sigmoidf_(lg.y), s2 = sigmoidf_(lg.z), s3 = sigmoidf_(lg.w);
        const float c0 = s0 + rb.x, c1 = s1 + rb.y, c2 = s2 + rb.z, c3 = s3 + rb.w;
        float m1 = fmaxf(c0, c1), m2 = fminf(c0, c1);
        m2 = fmaxf(m2, fminf(m1, c2)); m1 = fmaxf(m1, c2);
        m2 = fmaxf(m2, fminf(m1, c3)); m1 = fmaxf(m1, c3);
#pragma unroll
        for (int off = 1; off < 8; off <<= 1) { const float o1 = __shfl_xor(m1, off), o2 = __shfl_xor(m2, off);
            const float n2 = fmaxf(fminf(m1, o1), fmaxf(m2, o2)); m1 = fmaxf(m1, o1); m2 = n2; }
        const float gs = m1 + m2; const int mygrp = F.lane >> 3; int rk = 0;
#pragma unroll
        for (int g2 = 0; g2 < 8; ++g2) { const float og = __shfl(gs, 8 * g2); rk += ((og > gs) || (og == gs && g2 < mygrp)) ? 1 : 0; }
        const bool sel = rk < 4;
        const unsigned k0 = sel ? fkey(c0) : 0u, k1 = sel ? fkey(c1) : 0u, k2 = sel ? fkey(c2) : 0u, k3 = sel ? fkey(c3) : 0u;
        unsigned Tk = 0u;
#pragma unroll
        for (int bit = 31; bit >= 0; --bit) {
            const unsigned cand = Tk | (1u << bit);
            const int cnt = __builtin_popcountll(__ballot(k0 >= cand)) + __builtin_popcountll(__ballot(k1 >= cand)) + __builtin_popcountll(__ballot(k2 >= cand)) + __builtin_popcountll(__ballot(k3 >= cand));
            Tk = (cnt >= TOPK) ? cand : Tk;
        }
        const bool g0 = k0 > Tk, g1 = k1 > Tk, g2 = k2 > Tk, g3 = k3 > Tk, e0 = k0 == Tk, e1 = k1 == Tk, e2 = k2 == Tk, e3 = k3 == Tk;
        const int need = TOPK - (__builtin_popcountll(__ballot(g0)) + __builtin_popcountll(__ballot(g1)) + __builtin_popcountll(__ballot(g2)) + __builtin_popcountll(__ballot(g3)));
        int eqb = mbcnt64(__ballot(e0)) + mbcnt64(__ballot(e1)) + mbcnt64(__ballot(e2)) + mbcnt64(__ballot(e3));
        const bool x0 = g0 || (e0 && eqb < need); eqb += e0 ? 1 : 0;
        const bool x1 = g1 || (e1 && eqb < need); eqb += e1 ? 1 : 0;
        const bool x2 = g2 || (e2 && eqb < need); eqb += e2 ? 1 : 0;
        const bool x3 = g3 || (e3 && eqb < need);
        int pos = mbcnt64(__ballot(x0)) + mbcnt64(__ballot(x1)) + mbcnt64(__ballot(x2)) + mbcnt64(__ballot(x3));
        const float ssum = wave_sum((x0 ? s0 : 0.f) + (x1 ? s1 : 0.f) + (x2 ? s2 : 0.f) + (x3 ? s3 : 0.f));
        const float wsc = 2.5f / ssum;
#define ROUTE_EMIT(x, j, s) if (x) { const int e_ = 4 * F.lane + (j); const int rkl = __hip_atomic_fetch_add(hist + e_, 1, __ATOMIC_RELAXED, __HIP_MEMORY_SCOPE_WORKGROUP); \
            idxg[(size_t)t * TOPK + pos] = e_; wtg[(size_t)t * TOPK + pos] = (s) * wsc; rankg[(size_t)t * TOPK + pos] = rkl; ++pos; }
        ROUTE_EMIT(x0, 0, s0) ROUTE_EMIT(x1, 1, s1) ROUTE_EMIT(x2, 2, s2) ROUTE_EMIT(x3, 3, s3)
#undef ROUTE_EMIT
    }
    __syncthreads();
    if (F.tid < NE) bb[F.blk * NE + F.tid] = __hip_atomic_fetch_add(gcnt + F.tid, (unsigned)hist[F.tid], __ATOMIC_RELAXED, __HIP_MEMORY_SCOPE_AGENT);
}

__device__ __forceinline__ void phase_scatter(const Ctx& F) {
    const int* idxg = (const int*)(F.ws + WS_IDX); const float* wtg = (const float*)(F.ws + WS_WT); const int* rankg = (const int*)(F.ws + WS_RANK);
    int* posg = (int*)(F.ws + WS_POS); int* tokp = (int*)(F.ws + WS_TOKP); int* ypos = (int*)(F.ws + WS_YPOS); float* wpad = (float*)(F.ws + WS_WPAD);
    const unsigned* bb = (const unsigned*)(F.ws + WS_BB);
    const unsigned* gcnt = (const unsigned*)(F.ws + WS_CTL) + CW_GCNT;
    int* tile_e = (int*)(F.ws + WS_TILEE);
    LAS int* cnt = (LAS int*)(F.lds); LAS int* pst = cnt + 256; LAS int* cst = cnt + 512; LAS int* base = cnt + 768;
    __syncthreads();
    if (F.tid < NE) cnt[F.tid] = (int)__hip_atomic_load(gcnt + F.tid, __ATOMIC_RELAXED, __HIP_MEMORY_SCOPE_AGENT);
    __syncthreads();
    if (F.tid < NE) { int ps = 0, cs = 0; for (int e = 0; e < F.tid; ++e) { ps += (cnt[e] + 255) & ~255; cs += cnt[e]; } pst[F.tid] = ps; cst[F.tid] = cs; base[F.tid] = (int)bb[F.blk * NE + F.tid]; }
    __syncthreads();
    const int tpb = (T + F.G - 1) / F.G, t0 = F.blk * tpb, t1 = (t0 + tpb < T) ? t0 + tpb : T;
    for (int i = t0 * TOPK + F.tid; i < t1 * TOPK; i += NTHR) {
        const int e = idxg[i], r = rankg[i] + base[e], p = pst[e] + r, cp = cst[e] + r;
        tokp[p] = i >> 3; ypos[p] = cp; wpad[p] = wtg[i]; posg[i] = cp;
    }
    for (int e = F.blk; e < NE; e += F.G) {
        const int ps = pst[e], n = cnt[e], pe = ps + ((n + 255) & ~255);
        for (int p = ps + n + F.tid; p < pe; p += NTHR) { tokp[p] = -1; ypos[p] = -1; wpad[p] = 0.f; }
        for (int tl = ps / 256 + F.tid; tl < pe / 256; tl += NTHR) tile_e[tl] = e;
        if (e == NE - 1 && F.tid == 0) ((unsigned*)(F.ws + WS_CTL))[CW_NRT] = (unsigned)(pe / 256);
    }
    for (int t = F.blk * NTHR + F.tid; t < T; t += F.G * NTHR) { tokp[PADCAP + t] = t; ypos[PADCAP + t] = NASSIGN + t; wpad[PADCAP + t] = 1.0f; }
    for (int s = F.blk * NTHR + F.tid; s < T / 256; s += F.G * NTHR) tile_e[SH_TILE0 + s] = NE;
}

template <int STAGE> __device__ __forceinline__ void phase_moe(const Ctx& F) {
    const int* tokp = (const int*)(F.ws + WS_TOKP); const int* ypos = (const int*)(F.ws + WS_YPOS); const float* wpad = (const float*)(F.ws + WS_WPAD);
    const int* tile_e = (const int*)(F.ws + WS_TILEE);
    const int nrt = (int)__hip_atomic_load((unsigned*)(F.ws + WS_CTL) + CW_NRT, __ATOMIC_RELAXED, __HIP_MEMORY_SCOPE_AGENT);
    const int ntl = nrt + T / 256;
    const bf16* h2 = (const bf16*)(F.ws + WS_A2);
    bf16* hid = (bf16*)(F.ws + WS_A3);
    unsigned char* Y = (unsigned char*)(F.ws + WS_Y);
    const int r32 = F.lane & 31, hi = F.lane >> 5, wm = F.wave >> 2, wn = F.wave & 3;
    const int prow = F.tid >> 3, pch = F.tid & 7;
    constexpr int NPN = (STAGE == 1) ? 2 : 4, K = (STAGE == 1) ? 1024 : 256;
    const int nU = ntl * 2 * NPN;
    for (int u = F.blk; u < nU; u += F.G) {
        const int pn = u % NPN, hm = (u / NPN) & 1, tq = u / (2 * NPN);
        const int tile = tq < nrt ? tq : SH_TILE0 + (tq - nrt);
        const int e = tile_e[tile], p0 = tile * 256 + hm * 128;
        if (tokp[p0] < 0) continue;
        const char *pa0, *pa1;
        if (STAGE == 1) { int ta = tokp[p0 + prow], tb = tokp[p0 + prow + 64]; ta = ta < 0 ? 0 : ta; tb = tb < 0 ? 0 : tb;
            pa0 = (const char*)(h2 + (size_t)ta * DM) + pch * 16; pa1 = (const char*)(h2 + (size_t)tb * DM) + pch * 16; }
        else { pa0 = (const char*)(hid + (size_t)(p0 + prow) * EDIM) + pch * 16; pa1 = pa0 + 64 * EDIM * 2; }
        const bf16* Bt = (STAGE == 1) ? (const bf16*)(F.ws + WS_WGU) + (size_t)e * 512 * 1024 : (const bf16*)(F.ws + WS_WD) + (size_t)e * 1024 * 256;
        const char* pb0 = (const char*)(Bt + (size_t)(pn * 256 + prow) * K) + pch * 16;
        const size_t bs = (size_t)64 * K * 2;
        f32x16 acc[2][2];
        sg_mainloop(F.lds, pa0, pa1, pb0, pb0 + bs, pb0 + 2 * bs, pb0 + 3 * bs, K, acc);
#pragma unroll
        for (int mt = 0; mt < 2; ++mt) {
            const int p = p0 + wm * 64 + mt * 32 + r32;
            if (STAGE == 1) {
#pragma unroll
                for (int rg = 0; rg < 4; ++rg) {
                    float hv[4];
#pragma unroll
                    for (int q = 0; q < 4; ++q) { const float gt = acc[mt][0][4 * rg + q], up = acc[mt][1][4 * rg + q]; hv[q] = gt * sigmoidf_(gt) * up; }
                    u32x2 w; w.x = pk2(hv[0], hv[1]); w.y = pk2(hv[2], hv[3]);
                    *(u32x2*)(hid + (size_t)p * EDIM + pn * 128 + wn * 32 + 8 * rg + 4 * hi) = w;
                }
            } else {
                const int tk = tokp[p];
                if (tk >= 0) {
                    const float wv = wpad[p] * Y8_SCALE; unsigned char* yr = Y + (size_t)ypos[p] * DM + pn * 256;
#pragma unroll
                    for (int j = 0; j < 2; ++j)
#pragma unroll
                        for (int rg = 0; rg < 4; ++rg) { int t = 0; t = __builtin_amdgcn_cvt_pk_fp8_f32(acc[mt][j][4 * rg] * wv, acc[mt][j][4 * rg + 1] * wv, t, false);
                            t = __builtin_amdgcn_cvt_pk_fp8_f32(acc[mt][j][4 * rg + 2] * wv, acc[mt][j][4 * rg + 3] * wv, t, true);
                            *(unsigned*)(yr + j * 128 + wn * 32 + 8 * rg + 4 * hi) = (unsigned)t; }
                }
            }
        }
    }
}

__device__ __forceinline__ void phase_combine(const Ctx& F) { const float* const p_gff = F.in(13);
    const int gw = F.blk * NWAVES + F.wave, NGW = F.G * NWAVES;
    const float* mod = (const float*)(F.ws + WS_MOD);
    const int* posg = (const int*)(F.ws + WS_POS);
    const unsigned char* Y = (const unsigned char*)(F.ws + WS_Y); const bf16* xmid = (const bf16*)(F.ws + WS_XMID);
    typedef float f32x2 __attribute__((ext_vector_type(2)));
    for (int ch = gw; ch < T / 16; ch += NGW) {
        const int row0 = ch * 16, b = row0 / SEQ;
        f32x4 gg[4];
#pragma unroll
        for (int j = 0; j < 4; ++j) { const int col = 16 * F.lane + 4 * j; gg[j] = *(const f32x4*)(p_gff + col) * *(const f32x4*)(mod + b * 6144 + 5 * 1024 + col); }
        for (int rr = 0; rr < 16; ++rr) {
            const int t = row0 + rr;
            f32x4 y[4];
#pragma unroll
            for (int j = 0; j < 4; ++j) y[j] = (f32x4){0.f, 0.f, 0.f, 0.f};
            u32x4 w[TOPK + 1];
#pragma unroll
            for (int k = 0; k < TOPK + 1; ++k) { const size_t yr = (k < TOPK) ? (size_t)posg[(size_t)t * TOPK + k] : (size_t)(NASSIGN + t); w[k] = *(const u32x4*)(Y + yr * DM + 16 * F.lane); }
#pragma unroll
            for (int k = 0; k < TOPK + 1; ++k)
#pragma unroll
                for (int j = 0; j < 4; ++j) { const f32x2 lo = __builtin_amdgcn_cvt_pk_f32_fp8((int)w[k][j], false), hi = __builtin_amdgcn_cvt_pk_f32_fp8((int)w[k][j], true);
                    y[j] += (f32x4){lo.x, lo.y, hi.x, hi.y}; }
            float s = 0.f;
#pragma unroll
            for (int j = 0; j < 4; ++j) { y[j] = y[j] * (1.0f / Y8_SCALE); s += (y[j].x * y[j].x + y[j].y * y[j].y) + (y[j].z * y[j].z + y[j].w * y[j].w); }
            const float r = 1.0f / sqrtf(wave_sum(s) * (1.f / DM) + RMS_EPS);
            const u32x4 xw0 = *(const u32x4*)(xmid + (size_t)t * DM + 16 * F.lane), xw1 = *(const u32x4*)(xmid + (size_t)t * DM + 16 * F.lane + 8);
            const f32x4 xm[4] = {(f32x4){bflo(xw0.x), bfhi(xw0.x), bflo(xw0.y), bfhi(xw0.y)}, (f32x4){bflo(xw0.z), bfhi(xw0.z), bflo(xw0.w), bfhi(xw0.w)},
                                 (f32x4){bflo(xw1.x), bfhi(xw1.x), bflo(xw1.y), bfhi(xw1.y)}, (f32x4){bflo(xw1.z), bfhi(xw1.z), bflo(xw1.w), bfhi(xw1.w)}};
#pragma unroll
            for (int j = 0; j < 4; ++j) *(f32x4*)(F.out + (size_t)t * DM + 16 * F.lane + 4 * j) = xm[j] + y[j] * r * gg[j];
        }
    }
}

constexpr int NPHASE = 14;
struct Args { const float* in[22]; float* out; unsigned char* ws; int ph_lo, ph_hi, var, pad; };
__global__ void __launch_bounds__(NTHR, 2) fwd(Args args) {
    extern __shared__ __attribute__((aligned(16))) unsigned char lds[];
    Ctx F;
    F.lds = (LAS unsigned char*)lds;
    F.tid = threadIdx.x; F.lane = F.tid & 63; F.wave = __builtin_amdgcn_readfirstlane(F.tid >> 6); F.G = gridDim.x; F.blk = blockIdx.x;
    F.out = args.out; F.ws = args.ws;
    volatile LAS unsigned* misc = (volatile LAS unsigned*)(F.lds + LDS_BYTES - 64);
    if (F.tid < 16) misc[F.tid] = 0u;
    __syncthreads();
    const int lo = args.ph_lo, hi = args.ph_hi;
    XcdBarrier bar; bar.bar = (unsigned*)(F.ws + WS_CTL) + CW_BAR; bar.x = 0; bar.st = nullptr;
    if (hi - lo > 1) bar = xcd_barrier_post((unsigned*)(F.ws + WS_CTL) + CW_BAR, misc);
#define IN(k) (lo <= (k) && (k) < hi)
#define SEAM(k) do { if (IN(k) && IN((k) + 1)) xcd_barrier(bar); } while (0)
#define SEAMW(k, gu, r) do { if (IN(k) && IN((k) + 1)) { if (NEW_CVT && !CVT_IN_P0 && (r) * 2048 < ((gu) ? CVT_GB : CVT_DB)) { xcd_arrive(bar); cvt_experts<gu>(F, F.lds + F.wave * 8448, (r) * 2048, ((r) + 1) * 2048); xcd_wait(bar); } else xcd_barrier(bar); } } while (0)
    if (IN(0)) { phase_prologue(F); } SEAMW(0, true, 0);
    if (IN(1)) { phase_h(F); } SEAMW(1, true, 1);
    if (IN(2)) { if (FAST_DENSE) phase_dense_fast<0>(F); else phase_dense<0>(F); } SEAMW(2, true, 2);
    if (IN(3)) {
        if (NEW_CVT && !CVT_IN_P0 && !(F.blk & 1)) { cvt_experts<true>(F, F.lds + F.wave * 8448, CVT_G1, N_GU_ITEMS); __syncthreads(); }
        phase_swa(F); if (PROBE_ATT == 1) phase_swa(F); phase_sb(F); if (PROBE_ATT == 2) phase_sb(F);
        if (NEW_CVT && !CVT_IN_P0 && (F.blk & 1)) { __syncthreads(); cvt_experts<true>(F, F.lds + F.wave * 8448, CVT_G1, N_GU_ITEMS); }
    } SEAMW(3, true, 3);
    if (IN(4)) { if (FAST_DENSE) phase_dense_fast<1>(F); else phase_dense<1>(F); }
    if (IN(5)) { if (FAST_DENSE) phase_dense_fast<2>(F); else phase_dense<2>(F); } SEAMW(5, false, 0);
    if (IN(6)) { if (FAST_DENSE) phase_dense_fast<3>(F); else phase_dense<3>(F); } SEAMW(6, false, 1);
    if (IN(7)) { phase_mid(F); } SEAMW(7, false, 2);
    if (IN(8)) {
        if (FAST_DENSE) phase_dense_fast<4>(F); else phase_dense<4>(F);
        if (NEW_CVT && !CVT_IN_P0) { if (F.G == 256) { if (F.blk >= 128) cvt_experts_from<false>(F, F.lds + F.wave * 8448, CVT_DB + (F.blk - 128) * NWAVES + F.wave, 1024, N_D_ITEMS); }
                                     else cvt_experts<false>(F, F.lds + F.wave * 8448, CVT_DB, N_D_ITEMS); }
    } SEAMW(8, false, 3);
    if (IN(9)) { phase_route(F); } SEAMW(9, true, 4);
    if (IN(10)) { phase_scatter(F); } SEAM(10);
    if (IN(11)) { if (FAST_MOE) phase_moe_fast<1>(F); else phase_moe<1>(F); } SEAM(11);
    if (IN(12)) { if (FAST_MOE) phase_moe_fast<2>(F); else phase_moe<2>(F); } SEAM(12);
    if (IN(13)) { phase_combine(F); }
#undef IN
#undef SEAM
}

extern "C" void kernel_launch(void* const* d_in, const int* in_sizes, int n_in, void* d_out, int out_size, void* d_ws, size_t ws_size, hipStream_t stream) {
    static int grid = 0;
    if (grid == 0) {
        if (n_in != 22 || in_sizes[0] != T * DM || out_size != T * DM || ws_size < WS_END) { fprintf(stderr, "kernel_launch: unexpected shapes (n_in %d, in0 %d, out %d, ws %zu); nothing launched\n", n_in, n_in > 0 ? in_sizes[0] : -1, out_size, ws_size); grid = -1; return; }
        int dev = 0, cus = 0, per_cu = 0;
        if (hipGetDevice(&dev) != hipSuccess || hipDeviceGetAttribute(&cus, hipDeviceAttributeMultiprocessorCount, dev) != hipSuccess) { grid = -1; return; }
        if (hipFuncSetAttribute((const void*)fwd, hipFuncAttributeMaxDynamicSharedMemorySize, LDS_BYTES) != hipSuccess) { grid = -1; return; }
        if (hipOccupancyMaxActiveBlocksPerMultiprocessor(&per_cu, (const void*)fwd, NTHR, LDS_BYTES) != hipSuccess || per_cu < 1) { fprintf(stderr, "kernel_launch: occupancy query says %d\n", per_cu); }
        (void)hipGetLastError();
        grid = cus;
    }
    if (grid < 0) return;
    (void)hipMemsetAsync((char*)d_ws + WS_CTL, 0, CTL_ZERO_BYTES, stream);
    Args a{};
    for (int i = 0; i < 22; ++i) a.in[i] = (const float*)d_in[i];
    a.out = (float*)d_out; a.ws = (unsigned char*)d_ws;
#if MK_ONE_LAUNCH
    a.ph_lo = 0; a.ph_hi = NPHASE;
    hipLaunchKernelGGL(fwd, dim3(grid), dim3(NTHR), LDS_BYTES, stream, a);
    if (PROBE_MOE2) { a.ph_lo = 12; a.ph_hi = 13; a.var = PROBE_MOE2; hipLaunchKernelGGL(fwd, dim3(grid), dim3(NTHR), LDS_BYTES, stream, a); }
#else
    for (int p = 0; p < NPHASE; ++p) { a.ph_lo = p; a.ph_hi = p + 1; hipLaunchKernelGGL(fwd, dim3(grid), dim3(NTHR), LDS_BYTES, stream, a); }
#endif
}
```
